# Optimizing an MI355X kernel written in HIP

```python
import math
import jax
import jax.numpy as jnp
from jax import lax
import numpy as np


D_MODEL = 1024
BATCH = 1
SEQ = 16384
DEPTH = 2
DEC_BATCH = 16
DEC_SEQ = 16
PAST_LEN = 4096

CHUNK = 64
EPS = 1e-6
N_AB = (DEPTH + 1) // 2
N_C = DEPTH // 2

POOL_WINDOWS = (2, 4, 8, 16)
POOL_GROUPS = 4
POOL_DIM = D_MODEL // 2
POOL_GDIM = POOL_DIM // POOL_GROUPS
POOL_HIST = max(POOL_WINDOWS) - 1

MLA_HEADS = 8
QK_NOPE = 64
QK_ROPE = 32
V_HEAD = 64
Q_LORA = 384
KV_LORA = 256
MLA_OUT = MLA_HEADS * V_HEAD
ROPE_THETA = 10000.0
Q_BLOCK = 128
SM_SCALE = (QK_NOPE + QK_ROPE) ** -0.5
IN_AB = POOL_DIM + Q_LORA + KV_LORA + QK_ROPE
NEG = -1e30

D_INNER = 2 * D_MODEL
SSM_HEADDIM = 64
SSM_HEADS = D_INNER // SSM_HEADDIM
SSM_GROUPS = 4
SSM_HPG = SSM_HEADS // SSM_GROUPS
D_STATE = 128
D_CONV = 4
CONV_DIM = D_INNER + 2 * SSM_GROUPS * D_STATE
IN_C = D_INNER + CONV_DIM + SSM_HEADS

D_FF = -(-8 * D_MODEL // (3 * 256)) * 256

kernel_name = 'hybrid_pool_mla_ssd_stream_step'


def rmsnorm(x, g):
    xf = x.astype(jnp.float32)
    y = xf * lax.rsqrt(jnp.mean(xf * xf, axis=-1, keepdims=True) + EPS)
    return (y * g.astype(jnp.float32)).astype(x.dtype)


def swiglu(h, w_gate, w_up, w_down):
    return (jax.nn.silu(h @ w_gate) * (h @ w_up)) @ w_down


def rope_tables(pos):
    half = QK_ROPE // 2
    inv = ROPE_THETA ** (-jnp.arange(half, dtype=jnp.float32) / half)
    ang = pos.astype(jnp.float32)[:, None] * inv[None, :]
    return jnp.cos(ang), jnp.sin(ang)


def apply_rope(x, cos, sin):
    half = QK_ROPE // 2
    extra = x.ndim - 3
    cos = cos.reshape(cos.shape[:1] + (1,) * extra + cos.shape[1:])
    sin = sin.reshape(sin.shape[:1] + (1,) * extra + sin.shape[1:])
    xf = x.astype(jnp.float32)
    x1, x2 = xf[..., :half], xf[..., half:]
    return jnp.concatenate([x1 * cos - x2 * sin, x2 * cos + x1 * sin], axis=-1).astype(x.dtype)


def pool_mix(full, pos0, w_pool, pool_scale):
    b, tot, _ = full.shape
    s = tot - POOL_HIST
    ff = full.astype(jnp.float32)
    cs = jnp.cumsum(ff, axis=1)
    cs = jnp.concatenate([jnp.zeros_like(cs[:, :1]), cs], axis=1)
    pos = pos0 + jnp.arange(s)
    outs = []
    for g, w in enumerate(POOL_WINDOWS):
        sl = slice(g * POOL_GDIM, (g + 1) * POOL_GDIM)
        win_sum = cs[:, POOL_HIST + 1:POOL_HIST + 1 + s, sl] - cs[:, POOL_HIST + 1 - w:POOL_HIST + 1 - w + s, sl]
        cnt = jnp.minimum(pos + 1, w).astype(jnp.float32)[None, :, None]
        outs.append(win_sum / cnt - ff[:, POOL_HIST:, sl])
    pooled = jnp.stack(outs, axis=2)
    mixed = jnp.einsum('bsgc,gcd->bsgd', pooled, w_pool.astype(jnp.float32)).reshape(b, s, POOL_DIM)
    return (mixed * pool_scale.astype(jnp.float32)).astype(full.dtype)


def mla_attend(q_nope, q_pe, ckv, kpe, q_pos, k_pos, w_uk, w_uv):
    b, sq = q_nope.shape[:2]
    k_nope = jnp.einsum('bkc,chd->bkhd', ckv, w_uk)
    v = jnp.einsum('bkc,chd->bkhd', ckv, w_uv)
    k_chunk = k_pos // CHUNK
    qb = Q_BLOCK if sq % Q_BLOCK == 0 else sq
    nb = sq // qb

    def block(args):
        qn, qp, qpos = args
        s = (jnp.einsum('bqhd,bkhd->bhqk', qn, k_nope)
             + jnp.einsum('bqhr,bkr->bhqk', qp, kpe)).astype(jnp.float32) * SM_SCALE
        mask = k_chunk[None, :] <= (qpos // CHUNK)[:, None]
        s = jnp.where(mask[None, None], s, NEG)
        p = jax.nn.softmax(s, axis=-1).astype(v.dtype)
        return jnp.einsum('bhqk,bkhd->bqhd', p, v)

    qn_b = jnp.moveaxis(q_nope.reshape(b, nb, qb, MLA_HEADS, QK_NOPE), 1, 0)
    qp_b = jnp.moveaxis(q_pe.reshape(b, nb, qb, MLA_HEADS, QK_ROPE), 1, 0)
    pos_b = q_pos.reshape(nb, qb)
    out = lax.map(block, (qn_b, qp_b, pos_b))
    return jnp.moveaxis(out, 0, 1).reshape(b, sq, MLA_OUT)


def mixer_ab(h, pos0, pool_hist, ckv_past, kpe_past, w_in, w_pool, pool_scale, q_norm, w_uq,
             kv_norm, w_uk, w_uv, w_out):
    b, s, _ = h.shape
    proj = h @ w_in
    o1 = POOL_DIM
    o2 = o1 + Q_LORA
    o3 = o2 + KV_LORA
    u_pool, q_lat, kv_lat, k_pe = proj[..., :o1], proj[..., o1:o2], proj[..., o2:o3], proj[..., o3:]
    pool_full = jnp.concatenate([pool_hist.astype(h.dtype), u_pool], axis=1)
    pool_out = pool_mix(pool_full, pos0, w_pool, pool_scale)
    new_pool = pool_full[:, -POOL_HIST:]
    pos = pos0 + jnp.arange(s)
    cos, sin = rope_tables(pos)
    q = (rmsnorm(q_lat, q_norm) @ w_uq).reshape(b, s, MLA_HEADS, QK_NOPE + QK_ROPE)
    q_nope = q[..., :QK_NOPE]
    q_pe = apply_rope(q[..., QK_NOPE:], cos, sin)
    ckv = rmsnorm(kv_lat, kv_norm)
    kpe = apply_rope(k_pe, cos, sin)
    ckv_all = jnp.concatenate([ckv_past.astype(h.dtype), ckv], axis=1)
    kpe_all = jnp.concatenate([kpe_past.astype(h.dtype), kpe], axis=1)
    k_pos = pos0 - ckv_past.shape[1] + jnp.arange(ckv_all.shape[1])
    attn = mla_attend(q_nope, q_pe, ckv_all, kpe_all, pos, k_pos, w_uk, w_uv)
    y = jnp.concatenate([pool_out, attn], axis=-1) @ w_out
    return y, new_pool, ckv, kpe


def ssd_scan(x, dt, a, bm, cm, h0):
    b, s = x.shape[:2]
    ln = CHUNK if s % CHUNK == 0 else s
    nc = s // ln

    def chunks(t):
        return jnp.moveaxis(t.reshape((b, nc, ln) + t.shape[2:]), 1, 0)

    xs = chunks(x.astype(jnp.float32).reshape(b, s, SSM_GROUPS, SSM_HPG, SSM_HEADDIM))
    dts = chunks(dt.reshape(b, s, SSM_GROUPS, SSM_HPG))
    bs = chunks(bm.astype(jnp.float32))
    cs = chunks(cm.astype(jnp.float32))
    a_g = a.reshape(SSM_GROUPS, SSM_HPG)
    causal = jnp.tril(jnp.ones((ln, ln), dtype=bool))

    def step(h, inp):
        xc, dtc, bc, cc = inp
        acum = jnp.cumsum(dtc * a_g, axis=1)
        seg = acum[:, :, None] - acum[:, None, :]
        decay = jnp.exp(jnp.where(causal[None, :, :, None, None], seg, -jnp.inf))
        scores = jnp.einsum('bign,bjgn->bijg', cc, bc)[..., None] * decay * dtc[:, None]
        y = jnp.einsum('bijgh,bjghp->bighp', scores, xc)
        y = y + jnp.einsum('bign,bghpn->bighp', cc, h) * jnp.exp(acum)[..., None]
        last = acum[:, -1]
        wj = jnp.exp(last[:, None] - acum) * dtc
        h = h * jnp.exp(last)[..., None, None] + jnp.einsum('bjgh,bjgn,bjghp->bghpn', wj, bc, xc)
        return h, y

    hinit = h0.astype(jnp.float32).reshape(b, SSM_GROUPS, SSM_HPG, SSM_HEADDIM, D_STATE)
    h_fin, ys = lax.scan(step, hinit, (xs, dts, bs, cs))
    y = jnp.moveaxis(ys, 0, 1).reshape(b, s, SSM_HEADS, SSM_HEADDIM)
    return y, h_fin.reshape(b, SSM_HEADS, SSM_HEADDIM, D_STATE)


def mixer_c(h, conv_hist, ssm_hist, w_in, conv_w, conv_b, dt_bias, a_log, d_skip, ssm_norm, w_out):
    b, s, _ = h.shape
    proj = h @ w_in
    z = proj[..., :D_INNER]
    xbc = proj[..., D_INNER:D_INNER + CONV_DIM]
    dt_raw = proj[..., D_INNER + CONV_DIM:]
    xbc_full = jnp.concatenate([conv_hist.astype(h.dtype), xbc], axis=1)
    new_conv = xbc_full[:, -(D_CONV - 1):]
    conv = lax.conv_general_dilated(xbc_full, conv_w[:, None, :].astype(h.dtype), window_strides=(1,),
                                    padding='VALID', dimension_numbers=('NWC', 'WIO', 'NWC'),
                                    feature_group_count=CONV_DIM)
    xbc = jax.nn.silu(conv + conv_b)
    gn = SSM_GROUPS * D_STATE
    xs = xbc[..., :D_INNER].reshape(b, s, SSM_HEADS, SSM_HEADDIM)
    bm = xbc[..., D_INNER:D_INNER + gn].reshape(b, s, SSM_GROUPS, D_STATE)
    cm = xbc[..., D_INNER + gn:].reshape(b, s, SSM_GROUPS, D_STATE)
    dt = jax.nn.softplus(dt_raw.astype(jnp.float32) + dt_bias.astype(jnp.float32))
    a = -jnp.exp(a_log.astype(jnp.float32))
    y, new_h = ssd_scan(xs, dt, a, bm, cm, ssm_hist)
    y = y + xs.astype(jnp.float32) * d_skip.astype(jnp.float32)[:, None]
    y = y.reshape(b, s, D_INNER) * jax.nn.silu(z.astype(jnp.float32))
    yg = y.reshape(b, s, SSM_GROUPS, D_INNER // SSM_GROUPS)
    yg = yg * lax.rsqrt(jnp.mean(yg * yg, axis=-1, keepdims=True) + EPS)
    y = (yg.reshape(b, s, D_INNER) * ssm_norm.astype(jnp.float32)).astype(h.dtype)
    return y @ w_out, new_conv, new_h


def trunk(x, pos0, ckv_past, kpe_past, pool_hist, conv_hist, ssm_hist, norm_mix, norm_ffn, norm_final,
          w_in_ab, w_pool, pool_scale, q_norm, w_uq, kv_norm, w_uk, w_uv, w_out_ab, w_in_c, conv_w,
          conv_b, dt_bias, a_log, d_skip, ssm_norm, w_out_c, w_gate, w_up, w_down):
    ckv_new, kpe_new, pool_new, conv_new, ssm_new = [], [], [], [], []
    for layer in range(DEPTH):
        i = layer // 2
        h = rmsnorm(x, norm_mix[layer])
        if layer % 2 == 0:
            y, p, c, k = mixer_ab(h, pos0, pool_hist[i], ckv_past[i], kpe_past[i], w_in_ab[i], w_pool[i],
                                  pool_scale[i], q_norm[i], w_uq[i], kv_norm[i], w_uk[i], w_uv[i],
                                  w_out_ab[i])
            pool_new.append(p)
            ckv_new.append(c)
            kpe_new.append(k)
        else:
            y, cv, st = mixer_c(h, conv_hist[i], ssm_hist[i], w_in_c[i], conv_w[i], conv_b[i],
                                dt_bias[i], a_log[i], d_skip[i], ssm_norm[i], w_out_c[i])
            conv_new.append(cv)
            ssm_new.append(st)
        x = x + y
        x = x + swiglu(rmsnorm(x, norm_ffn[layer]), w_gate[layer], w_up[layer], w_down[layer])
    return (rmsnorm(x, norm_final), jnp.stack(ckv_new), jnp.stack(kpe_new), jnp.stack(pool_new),
            jnp.stack(conv_new), jnp.stack(ssm_new))


def setup_inputs(seed: int = 0) -> dict:
    key = jax.random.key(seed)
    ks = jax.random.split(key, 32)

    def nrm(i, shape, scale=1.0):
        return scale * jax.random.normal(ks[i], shape, jnp.float32)

    dt0 = jnp.exp(jax.random.uniform(ks[22], (N_C, SSM_HEADS), jnp.float32,
                                     minval=math.log(1e-3), maxval=math.log(1e-1)))
    return {
        'x_prompt': nrm(0, (BATCH, SEQ, D_MODEL)),
        'x_sample': nrm(1, (DEC_BATCH, DEC_SEQ, D_MODEL)),
        'cache_ckv': nrm(2, (N_AB, DEC_BATCH, PAST_LEN, KV_LORA)),
        'cache_kpe': nrm(3, (N_AB, DEC_BATCH, PAST_LEN, QK_ROPE)),
        'state_pool': nrm(4, (N_AB, DEC_BATCH, POOL_HIST, POOL_DIM)),
        'state_conv': nrm(5, (N_C, DEC_BATCH, D_CONV - 1, CONV_DIM)),
        'state_ssm': nrm(6, (N_C, DEC_BATCH, SSM_HEADS, SSM_HEADDIM, D_STATE), 0.3),
        'norm_mix': 1.0 + nrm(7, (DEPTH, D_MODEL), 0.01),
        'norm_ffn': 1.0 + nrm(8, (DEPTH, D_MODEL), 0.01),
        'norm_final': 1.0 + nrm(9, (D_MODEL,), 0.01),
        'w_in_ab': nrm(10, (N_AB, D_MODEL, IN_AB), D_MODEL ** -0.5),
        'w_pool': nrm(11, (N_AB, POOL_GROUPS, POOL_GDIM, POOL_GDIM), POOL_GDIM ** -0.5),
        'pool_scale': 1.0 + nrm(12, (N_AB, POOL_DIM), 0.1),
        'q_norm': 1.0 + nrm(13, (N_AB, Q_LORA), 0.01),
        'w_uq': nrm(14, (N_AB, Q_LORA, MLA_HEADS * (QK_NOPE + QK_ROPE)), Q_LORA ** -0.5),
        'kv_norm': 1.0 + nrm(15, (N_AB, KV_LORA), 0.01),
        'w_uk': nrm(16, (N_AB, KV_LORA, MLA_HEADS, QK_NOPE), KV_LORA ** -0.5),
        'w_uv': nrm(17, (N_AB, KV_LORA, MLA_HEADS, V_HEAD), KV_LORA ** -0.5),
        'w_out_ab': nrm(18, (N_AB, POOL_DIM + MLA_OUT, D_MODEL), (POOL_DIM + MLA_OUT) ** -0.5),
        'w_in_c': nrm(19, (N_C, D_MODEL, IN_C), D_MODEL ** -0.5),
        'conv_w': nrm(20, (N_C, D_CONV, CONV_DIM), D_CONV ** -0.5),
        'conv_b': nrm(21, (N_C, CONV_DIM), 0.02),
        'dt_bias': dt0 + jnp.log(-jnp.expm1(-dt0)),
        'a_log': jnp.log(jax.random.uniform(ks[23], (N_C, SSM_HEADS), jnp.float32, minval=1.0, maxval=16.0)),
        'd_skip': 1.0 + nrm(24, (N_C, SSM_HEADS), 0.1),
        'ssm_norm': 1.0 + nrm(25, (N_C, D_INNER), 0.01),
        'w_out_c': nrm(26, (N_C, D_INNER, D_MODEL), D_INNER ** -0.5),
        'w_gate': nrm(27, (DEPTH, D_MODEL, D_FF), D_MODEL ** -0.5),
        'w_up': nrm(28, (DEPTH, D_MODEL, D_FF), D_MODEL ** -0.5),
        'w_down': nrm(29, (DEPTH, D_FF, D_MODEL), D_FF ** -0.5),
    }


def reference(x_prompt, x_sample, cache_ckv, cache_kpe, state_pool, state_conv, state_ssm,
              norm_mix, norm_ffn, norm_final, w_in_ab, w_pool, pool_scale, q_norm, w_uq, kv_norm,
              w_uk, w_uv, w_out_ab, w_in_c, conv_w, conv_b, dt_bias, a_log, d_skip, ssm_norm,
              w_out_c, w_gate, w_up, w_down):
    weights = (norm_mix, norm_ffn, norm_final, w_in_ab, w_pool, pool_scale, q_norm, w_uq, kv_norm,
               w_uk, w_uv, w_out_ab, w_in_c, conv_w, conv_b, dt_bias, a_log, d_skip, ssm_norm,
               w_out_c, w_gate, w_up, w_down)
    b = x_prompt.shape[0]
    dtp = x_prompt.dtype
    (y_prompt, ckv_p, kpe_p, pool_p, conv_p, ssm_p) = trunk(
        x_prompt, 0,
        jnp.zeros((N_AB, b, 0, KV_LORA), dtp), jnp.zeros((N_AB, b, 0, QK_ROPE), dtp),
        jnp.zeros((N_AB, b, POOL_HIST, POOL_DIM), dtp), jnp.zeros((N_C, b, D_CONV - 1, CONV_DIM), dtp),
        jnp.zeros((N_C, b, SSM_HEADS, SSM_HEADDIM, D_STATE), jnp.float32), *weights)
    (y_sample, ckv_s, kpe_s, pool_s, conv_s, ssm_s) = trunk(
        x_sample, cache_ckv.shape[2], cache_ckv, cache_kpe, state_pool, state_conv, state_ssm, *weights)
    return (y_prompt, y_sample, ckv_p, kpe_p, pool_p, conv_p, ssm_p, ckv_s, kpe_s, pool_s, conv_s, ssm_s)
```

```cpp
#include <hip/hip_runtime.h>
#include <hip/hip_cooperative_groups.h>
#include <cstdio>
namespace cg = cooperative_groups;

#define DEV __device__ __forceinline__
#define LAS __attribute__((address_space(3)))
typedef unsigned short bf16_t;
typedef short bf16x8 __attribute__((ext_vector_type(8)));
typedef short s16x4 __attribute__((ext_vector_type(4)));
typedef float f32x4 __attribute__((ext_vector_type(4)));
typedef float f32x2 __attribute__((ext_vector_type(2)));
typedef float f32x16 __attribute__((ext_vector_type(16)));
typedef unsigned u32x4 __attribute__((ext_vector_type(4)));
typedef unsigned u32x2 __attribute__((ext_vector_type(2)));
typedef __bf16 bf16v2 __attribute__((ext_vector_type(2)));

constexpr int T = 16640;
constexpr int TPR = 16384;
constexpr int TP = 16704;
constexpr int NTB = TP / 16;
constexpr int NK = 82176;
constexpr int SKV = 4112;
constexpr float EPS = 1e-6f;
constexpr float QSCALE = 0.10206207261596577f * 1.4426950408889634f;

constexpr size_t W_INAB = 0, W_POOL = 2621440, W_UQ = 3145728, W_UK = 3735552, W_UV = 3997696, W_OUTAB = 4259840, W_GU0 = 6356992, W_DN0 = 17891328;
constexpr size_t R1 = 25165824;
constexpr size_t KNOPE = R1, VT = KNOPE + 84148224, CAT = VT + 84148224, POOLED = CAT + 34078720, QLN = POOLED + 17039360;
constexpr size_t H0 = KNOPE, PROJ = VT;
constexpr size_t HF = R1, GF0 = R1 + 34078720;
constexpr size_t DTB = 0, CN = 2129920, W_OUTC = 19169280, W_GU1 = 0, W_DN1 = 11534336;
constexpr size_t ZB = 25165824, XRAW = 93323264, STATES = XRAW, RT = 161480704, BCRAW = RT, XTB = RT, H1 = RT + 34078720;
constexpr size_t RB = 229900288, BN = RB, BTB = RB + 17039360, W_INC = RB, DEC = 264044544;
constexpr size_t H2 = RT, GF1 = ZB;
constexpr size_t XBAR = DEC + 8192;
constexpr size_t PART = XBAR + 16384;
constexpr size_t PART8 = 240910336, PART13 = XRAW, PART16 = RT;
constexpr size_t WS_NEED = PART + 4194304;
constexpr size_t O_YS = 16777216, O_CKVP = 17039360, O_KPEP = 21233664, O_POOLP = 21757952, O_CONVP = 21765632, O_SSMP = 21774848,
                 O_CKVS = 22036992, O_KPES = 22102528, O_POOLS = 22110720, O_CONVS = 22233600, O_SSMS = 22381056;
constexpr size_t D_CKVALL = 0, D_QRAW = 42074112, D_KPEALL = O_SSMS * 4, D_ROPE = O_SSMS * 4 + 5259264;

struct Params { const float* in[30]; float* out; unsigned char* ws; };

DEV unsigned pk2(float a, float b) { f32x2 v = {a, b}; bf16v2 r = __builtin_convertvector(v, bf16v2); return __builtin_bit_cast(unsigned, r); }
DEV float bf2f(short v) { return __uint_as_float(((unsigned)(unsigned short)v) << 16); }
DEV float wave_sum(float v) {
#pragma unroll
    for (int o = 1; o < 64; o <<= 1) v += __shfl_xor(v, o);
    return v;
}
DEV float silu(float x) { return x * __builtin_amdgcn_rcpf(1.0f + __expf(-x)); }
DEV f32x16 mfma32(bf16x8 a, bf16x8 b, f32x16 c) { return __builtin_amdgcn_mfma_f32_32x32x16_bf16(a, b, c, 0, 0, 0); }
DEV f32x16 zero16() { f32x16 z;
#pragma unroll
    for (int i = 0; i < 16; ++i) z[i] = 0.f; return z; }
template <int BASE> DEV bf16x8 pack8(const f32x16& x) {
    u32x4 p; p.x = pk2(x[BASE], x[BASE + 1]); p.y = pk2(x[BASE + 2], x[BASE + 3]); p.z = pk2(x[BASE + 4], x[BASE + 5]); p.w = pk2(x[BASE + 6], x[BASE + 7]);
    return __builtin_bit_cast(bf16x8, p);
}
DEV bf16x8 cat4(s16x4 lo, s16x4 hi) { return __builtin_shufflevector(lo, hi, 0, 1, 2, 3, 4, 5, 6, 7); }
#define LDS_FENCE() asm volatile("s_waitcnt lgkmcnt(0)" ::: "memory")
DEV int otid() { int t = threadIdx.x; asm volatile("" : "+v"(t)); return t; }

namespace pg8 {
constexpr int BM = 256, BK = 64, HALF = 128, HTB = HALF * BK * 2, STAGE_BYTES = 8 * HTB, NXCD = 8, WGM = 8;
DEV int lds_byte(int r, int c) { const int st = (r >> 4) * 2 + (c >> 5), rr = r & 15, cc = c & 31, ob = rr * 64 + cc * 2; return st * 1024 + (ob ^ (((ob >> 9) & 1) << 5)); }
DEV void stage_rc(int b, int& R, int& C) { const int st = b / 1024, sb = b % 1024, swz = sb ^ (((sb >> 9) & 1) << 5); R = (st >> 1) * 16 + swz / 64; C = (st & 1) * 32 + (swz % 64) / 2; }
DEV int perm32(int rho) { const int n = rho >> 4, i = rho & 15; return 8 * (i >> 2) + 4 * n + (i & 3); }
struct Unit { int pm, pn, k0, nt, flag; };
struct Gemm { const bf16_t* A; const bf16_t* Bt; int lda, ldb, K; };
struct StaticOrder {
    int nM, nN, nwg, G, c;
    DEV void init(int M, int N, int G_, int c_) { nM = M / BM; nN = N / BM; nwg = nM * nN; G = G_; c = c_; }
    DEV bool next(int i, Unit& u) const {
        const long L = (long)i * G + c; if (L >= nwg) return false;
        int wgid = (int)L; { const int q = nwg / NXCD, r = nwg % NXCD, xcd = wgid % NXCD, off = wgid / NXCD; wgid = (xcd < r ? xcd * (q + 1) : r * (q + 1) + (xcd - r) * q) + off; }
        const int nig = WGM * nN, gid = wgid / nig, fm = gid * WGM, gsz = (nM - fm) < WGM ? (nM - fm) : WGM;
        u.pm = fm + ((wgid % nig) % gsz); u.pn = (wgid % nig) / gsz; u.k0 = 0; u.nt = 0; u.flag = 0; return true;
    }
};
struct SplitOrder {
    int pm0, nN, nsplit, ksplit, G, c;
    DEV bool next(int i, Unit& u) const {
        const long L = (long)i * G + c; if (L >= (long)nN * nsplit) return false;
        u.pm = pm0; u.pn = (int)(L % nN); u.k0 = (int)(L / nN) * ksplit; u.nt = ksplit / BK; u.flag = 1; return true;
    }
};
struct ChainOrder {
    StaticOrder a; SplitOrder b; int na;
    DEV void init() { na = a.c < a.nwg ? (a.nwg - 1 - a.c) / a.G + 1 : 0; }
    DEV bool next(int i, Unit& u) const { return i < na ? a.next(i, u) : b.next(i - na, u); }
};

template <class Epi, class Sched>
DEV void gemm_phase(LAS unsigned char* lds, const Gemm g, const Sched& S, const Epi& E) {
    const int tid = otid(), wid = __builtin_amdgcn_readfirstlane(tid >> 6), lane = tid & 63, wr = wid >> 2, wc = wid & 3, fr = lane & 15, fq = lane >> 4;
    const int nt_def = g.K / BK;
    unsigned voffA[2], voffB[2];
#pragma unroll
    for (int i = 0; i < 2; ++i) { int R, C; stage_rc(tid * 16 + i * 8192, R, C); const int Rb = Epi::PERM ? ((R & ~31) + perm32(R & 31)) : R;
        voffA[i] = (unsigned)(R * g.lda + C) * 2u; voffB[i] = (unsigned)(Rb * g.ldb + C) * 2u; }
    const size_t kstep = (size_t)(BK * 2);
    const size_t hstepA = (size_t)HALF * g.lda * 2, hstepB = (size_t)HALF * g.ldb * 2;
    const size_t tstepA = 2 * hstepA, tstepB = 2 * hstepB;
    const unsigned ldsw = (unsigned)wid * 1024u;
    const int aoff = lds_byte(wr * 64 + fr, fq * 8), boff = lds_byte(wc * 32 + fr, fq * 8);
#define PG8_SA(b, h) (((b) * 2 + (h)) * HTB)
#define PG8_SB(b, h) ((4 + (b) * 2 + (h)) * HTB)
#define PG8_STAGE(bufoff, gbase, voff) do { _Pragma("unroll") for (int _i = 0; _i < 2; ++_i) \
        __builtin_amdgcn_global_load_lds((const unsigned*)((const char*)(gbase) + (voff)[_i]), (LAS unsigned*)(lds + (bufoff) + ldsw + _i * 8192), 16, 0, 0); } while (0)
#define PG8_LDA(dst, b, h) do { _Pragma("unroll") for (int m = 0; m < 4; ++m) _Pragma("unroll") for (int k = 0; k < 2; ++k) dst[m][k] = *(const LAS bf16x8*)(lds + PG8_SA(b, h) + aoff + m * 2048 + k * 1024); } while (0)
#define PG8_LDB(dst, b, h) do { _Pragma("unroll") for (int n = 0; n < 2; ++n) _Pragma("unroll") for (int k = 0; k < 2; ++k) dst[n][k] = *(const LAS bf16x8*)(lds + PG8_SB(b, h) + boff + n * 2048 + k * 1024); } while (0)
#define PG8_MMA(ai, bj, At, Bt) do { __builtin_amdgcn_s_setprio(1); _Pragma("unroll") for (int m = 0; m < 4; ++m) _Pragma("unroll") for (int n = 0; n < 2; ++n) _Pragma("unroll") for (int k = 0; k < 2; ++k) \
        acc[ai][bj][m][n] = __builtin_amdgcn_mfma_f32_16x16x32_bf16(Bt[n][k], At[m][k], acc[ai][bj][m][n], 0, 0, 0); __builtin_amdgcn_s_setprio(0); } while (0)
#define PG8_WAIT_V(n) asm volatile("s_waitcnt vmcnt(" #n ")" ::: "memory")
#define PG8_WAIT_L(n) asm volatile("s_waitcnt lgkmcnt(" #n ")" ::: "memory")
#define PG8_BAR __builtin_amdgcn_s_barrier()
#define PG8_SCHED __builtin_amdgcn_sched_barrier(0)
    Unit cur, nxt; int ui = 0;
    if (!S.next(0, cur)) return;
    f32x4 acc[2][2][4][2];
#pragma unroll
    for (int a = 0; a < 2; ++a)
#pragma unroll
        for (int b = 0; b < 2; ++b)
#pragma unroll
            for (int m = 0; m < 4; ++m)
#pragma unroll
                for (int n = 0; n < 2; ++n) acc[a][b][m][n] = (f32x4){0.f, 0.f, 0.f, 0.f};
    bf16x8 At[4][2], B0[2][2], B1[2][2];
    const char* cA = (const char*)g.A + (size_t)cur.pm * tstepA + (size_t)cur.k0 * 2; const char* cB = (const char*)g.Bt + (size_t)cur.pn * tstepB + (size_t)cur.k0 * 2;
    PG8_STAGE(PG8_SB(0, 0), cB, voffB); PG8_STAGE(PG8_SA(0, 0), cA, voffA); PG8_STAGE(PG8_SB(0, 1), cB + hstepB, voffB); PG8_STAGE(PG8_SA(0, 1), cA + hstepA, voffA);
    if (wr == 1) PG8_BAR;
    PG8_WAIT_V(4); PG8_BAR;
    PG8_STAGE(PG8_SB(1, 0), cB + kstep, voffB); PG8_STAGE(PG8_SA(1, 0), cA + kstep, voffA); PG8_STAGE(PG8_SB(1, 1), cB + hstepB + kstep, voffB);
    PG8_WAIT_V(6); PG8_BAR;
    for (;;) {
        const bool has_next = S.next(ui + 1, nxt);
        const int nt = cur.nt ? cur.nt : nt_def;
        const char* nA = has_next ? (const char*)g.A + (size_t)nxt.pm * tstepA + (size_t)nxt.k0 * 2 : cA; const char* nB = has_next ? (const char*)g.Bt + (size_t)nxt.pn * tstepB + (size_t)nxt.k0 * 2 : cB;
        for (int t = 0; t < nt; t += 2) {
            const bool last = (t == nt - 2);
            const char* a1 = cA + (size_t)(t + 1) * kstep;
            const char* a2 = last ? nA : cA + (size_t)(t + 2) * kstep; const char* b2 = last ? nB : cB + (size_t)(t + 2) * kstep;
            const char* a3 = a2 + kstep; const char* b3 = b2 + kstep;
            PG8_LDB(B0, 0, 0); PG8_SCHED; PG8_LDA(At, 0, 0); PG8_STAGE(PG8_SA(1, 1), a1 + hstepA, voffA);
            PG8_WAIT_L(8); PG8_BAR; PG8_WAIT_L(0); PG8_MMA(0, 0, At, B0); PG8_BAR; PG8_SCHED;
            PG8_LDB(B1, 0, 1); PG8_STAGE(PG8_SB(0, 0), b2, voffB);
            PG8_BAR; PG8_WAIT_L(0); PG8_MMA(0, 1, At, B1); PG8_BAR;
            PG8_LDA(At, 0, 1); PG8_STAGE(PG8_SA(0, 0), a2, voffA);
            PG8_BAR; PG8_WAIT_L(0); PG8_MMA(1, 0, At, B0); PG8_BAR; PG8_SCHED;
            PG8_STAGE(PG8_SB(0, 1), b2 + hstepB, voffB);
            PG8_WAIT_V(6); PG8_BAR; PG8_MMA(1, 1, At, B1); PG8_BAR;
            PG8_LDB(B0, 1, 0); PG8_SCHED; PG8_LDA(At, 1, 0); PG8_STAGE(PG8_SA(0, 1), a2 + hstepA, voffA);
            PG8_WAIT_L(8); PG8_BAR; PG8_WAIT_L(0); PG8_MMA(0, 0, At, B0); PG8_BAR; PG8_SCHED;
            PG8_LDB(B1, 1, 1); PG8_STAGE(PG8_SB(1, 0), b3, voffB);
            PG8_BAR; PG8_WAIT_L(0); PG8_MMA(0, 1, At, B1); PG8_BAR;
            PG8_LDA(At, 1, 1); PG8_STAGE(PG8_SA(1, 0), a3, voffA);
            PG8_BAR; PG8_WAIT_L(0); PG8_MMA(1, 0, At, B0); PG8_BAR; PG8_SCHED;
            PG8_STAGE(PG8_SB(1, 1), b3 + hstepB, voffB);
            PG8_WAIT_V(6); PG8_BAR; PG8_MMA(1, 1, At, B1); PG8_BAR;
        }
        E(acc, cur, wr, wc, fr, fq);
        if (!has_next) break;
#pragma unroll
        for (int a = 0; a < 2; ++a)
#pragma unroll
            for (int b = 0; b < 2; ++b)
#pragma unroll
                for (int m = 0; m < 4; ++m)
#pragma unroll
                    for (int n = 0; n < 2; ++n) acc[a][b][m][n] = (f32x4){0.f, 0.f, 0.f, 0.f};
        cur = nxt; cA = nA; cB = nB; ++ui;
    }
    PG8_WAIT_V(0);
    if (wr == 0) PG8_BAR;
    PG8_BAR;
#undef PG8_SA
#undef PG8_SB
#undef PG8_STAGE
#undef PG8_LDA
#undef PG8_LDB
#undef PG8_MMA
#undef PG8_WAIT_V
#undef PG8_WAIT_L
#undef PG8_BAR
#undef PG8_SCHED
}
}

struct EpiBf16 {
    static constexpr bool PERM = true;
    bf16_t* O; size_t ldc; const float* cscale;
    DEV void operator()(const f32x4 (&acc)[2][2][4][2], const pg8::Unit& u, int wr, int wc, int fr, int fq) const {
        const int row0 = u.pm * 256 + wr * 64 + fr, col0 = u.pn * 256 + wc * 32 + 8 * fq;
        f32x4 sc[2][2];
#pragma unroll
        for (int bj = 0; bj < 2; ++bj)
#pragma unroll
            for (int n = 0; n < 2; ++n) sc[bj][n] = cscale ? *(const f32x4*)(cscale + col0 + bj * 128 + 4 * n) : (f32x4){1.f, 1.f, 1.f, 1.f};
#pragma unroll
        for (int ai = 0; ai < 2; ++ai)
#pragma unroll
            for (int m = 0; m < 4; ++m) { bf16_t* rowp = O + (size_t)(row0 + ai * 128 + m * 16) * ldc + col0;
#pragma unroll
                for (int bj = 0; bj < 2; ++bj) { const f32x4 v0 = acc[ai][bj][m][0] * sc[bj][0], v1 = acc[ai][bj][m][1] * sc[bj][1];
                    u32x4 w; w.x = pk2(v0[0], v0[1]); w.y = pk2(v0[2], v0[3]); w.z = pk2(v1[0], v1[1]); w.w = pk2(v1[2], v1[3]);
                    *(u32x4*)(rowp + bj * 128) = w; } }
    }
};
struct EpiSwiglu {
    static constexpr bool PERM = true;
    bf16_t* G;
    DEV void operator()(const f32x4 (&acc)[2][2][4][2], const pg8::Unit& u, int wr, int wc, int fr, int fq) const {
        const int row0 = u.pm * 256 + wr * 64 + fr, col0 = u.pn * 128 + wc * 16 + 4 * fq;
#pragma unroll
        for (int ai = 0; ai < 2; ++ai)
#pragma unroll
            for (int m = 0; m < 4; ++m) { bf16_t* rowp = G + (size_t)(row0 + ai * 128 + m * 16) * 2816 + col0;
#pragma unroll
                for (int bj = 0; bj < 2; ++bj) { const f32x4 g = acc[ai][bj][m][0], up = acc[ai][bj][m][1];
                    u32x2 w; w.x = pk2(silu(g[0]) * up[0], silu(g[1]) * up[1]); w.y = pk2(silu(g[2]) * up[2], silu(g[3]) * up[3]);
                    *(u32x2*)(rowp + bj * 64) = w; } }
    }
};
struct EpiRes {
    static constexpr bool PERM = false;
    float* X; const float* xp; const float* xs; int mode;
    DEV void operator()(const f32x4 (&acc)[2][2][4][2], const pg8::Unit& u, int wr, int wc, int fr, int fq) const {
        const int row0 = u.pm * 256 + wr * 64 + fr, col0 = u.pn * 256 + wc * 32 + 4 * fq;
        if (mode == 2) {
#pragma unroll
            for (int ai = 0; ai < 2; ++ai)
#pragma unroll
                for (int m = 0; m < 4; ++m) { float* op = X + (size_t)(row0 + ai * 128 + m * 16) * 1024 + col0;
#pragma unroll
                    for (int bj = 0; bj < 2; ++bj)
#pragma unroll
                        for (int n = 0; n < 2; ++n) { const f32x4 a = acc[ai][bj][m][n]; const int o = bj * 128 + n * 16;
                            unsafeAtomicAdd(op + o, a[0]); unsafeAtomicAdd(op + o + 1, a[1]); unsafeAtomicAdd(op + o + 2, a[2]); unsafeAtomicAdd(op + o + 3, a[3]); } }
            return;
        }
        if (mode == 3) {
#pragma unroll
            for (int ai = 0; ai < 2; ++ai)
#pragma unroll
                for (int m = 0; m < 4; ++m) { float* op = X + ((size_t)(u.k0 >> 8) * 256 + (row0 + ai * 128 + m * 16 - TPR)) * 1024 + col0;
#pragma unroll
                    for (int bj = 0; bj < 2; ++bj)
#pragma unroll
                        for (int n = 0; n < 2; ++n) *(f32x4*)(op + bj * 128 + n * 16) = acc[ai][bj][m][n]; }
            return;
        }
#pragma unroll
        for (int ai = 0; ai < 2; ++ai) {
            f32x4 bs[4][2][2];
#pragma unroll
            for (int m = 0; m < 4; ++m) { const int row = row0 + ai * 128 + m * 16;
                const float* bp = (mode == 0) ? (row < TPR ? xp + (size_t)row * 1024 : xs + (size_t)(row - TPR) * 1024) + col0 : X + (size_t)row * 1024 + col0;
#pragma unroll
                for (int bj = 0; bj < 2; ++bj)
#pragma unroll
                    for (int n = 0; n < 2; ++n) bs[m][bj][n] = *(const f32x4*)(bp + bj * 128 + n * 16); }
#pragma unroll
            for (int m = 0; m < 4; ++m) { float* op = X + (size_t)(row0 + ai * 128 + m * 16) * 1024 + col0;
#pragma unroll
                for (int bj = 0; bj < 2; ++bj)
#pragma unroll
                    for (int n = 0; n < 2; ++n) *(f32x4*)(op + bj * 128 + n * 16) = acc[ai][bj][m][n] + bs[m][bj][n]; }
        }
    }
};
struct EpiResChain {
    static constexpr bool PERM = false;
    EpiRes m, s;
    DEV void operator()(const f32x4 (&acc)[2][2][4][2], const pg8::Unit& u, int wr, int wc, int fr, int fq) const { if (u.flag) s(acc, u, wr, wc, fr, fq); else m(acc, u, wr, wc, fr, fq); }
};
struct EpiInC {
    static constexpr bool PERM = true;
    bf16_t* Z; bf16_t* XR; bf16_t* BC; float* DT; const float* dt_bias;
    DEV void operator()(const f32x4 (&acc)[2][2][4][2], const pg8::Unit& u, int wr, int wc, int fr, int fq) const {
        const int row0 = u.pm * 256 + wr * 64 + fr, cin = wc * 32 + 8 * fq;
        if (u.pn == 20) {
            if (wc == 0) {
                const f32x4 b0 = *(const f32x4*)(dt_bias + 8 * fq), b1 = *(const f32x4*)(dt_bias + 8 * fq + 4);
#pragma unroll
                for (int ai = 0; ai < 2; ++ai)
#pragma unroll
                    for (int m = 0; m < 4; ++m) { float* rp = DT + (size_t)(row0 + ai * 128 + m * 16) * 32 + 8 * fq;
                        f32x4 v0 = acc[ai][0][m][0] + b0, v1 = acc[ai][0][m][1] + b1;
#pragma unroll
                        for (int j = 0; j < 4; ++j) { v0[j] = v0[j] > 20.f ? v0[j] : log1pf(__expf(v0[j])); v1[j] = v1[j] > 20.f ? v1[j] : log1pf(__expf(v1[j])); }
                        *(f32x4*)rp = v0; *(f32x4*)(rp + 4) = v1; }
            }
            return;
        }
        bf16_t* base; size_t ldc; int colt;
        if (u.pn < 8) { base = Z; ldc = 2048; colt = u.pn * 256; } else if (u.pn < 16) { base = XR; ldc = 2048; colt = (u.pn - 8) * 256; } else { base = BC; ldc = 1024; colt = (u.pn - 16) * 256; }
#pragma unroll
        for (int ai = 0; ai < 2; ++ai)
#pragma unroll
            for (int m = 0; m < 4; ++m) { bf16_t* rowp = base + (size_t)(row0 + ai * 128 + m * 16) * ldc + colt + cin;
#pragma unroll
                for (int bj = 0; bj < 2; ++bj) { const f32x4 v0 = acc[ai][bj][m][0], v1 = acc[ai][bj][m][1];
                    u32x4 w; w.x = pk2(v0[0], v0[1]); w.y = pk2(v0[2], v0[3]); w.z = pk2(v1[0], v1[1]); w.w = pk2(v1[2], v1[3]);
                    *(u32x4*)(rowp + bj * 128) = w; } }
    }
};

DEV void transpose_item(const float* __restrict__ W, int N, bf16_t* WT, int ldk, int koff, int row_off, int mode, float* scr, int kb, int nb, int lane) {
    const int k0 = 64 * kb, n0 = 32 * nb;
#pragma unroll 8
    for (int i = 0; i < 32; ++i) { const int kk = 2 * i + (lane >> 5); scr[kk * 33 + (lane & 31)] = W[(size_t)(k0 + kk) * N + n0 + (lane & 31)]; }
    LDS_FENCE();
    const int c = lane & 7;
#pragma unroll
    for (int j = 0; j < 4; ++j) { const int nl = (lane >> 3) + 8 * j, n = n0 + nl; const float* s = scr + (8 * c) * 33 + nl;
        u32x4 o; o.x = pk2(s[0 * 33], s[1 * 33]); o.y = pk2(s[2 * 33], s[3 * 33]); o.z = pk2(s[4 * 33], s[5 * 33]); o.w = pk2(s[6 * 33], s[7 * 33]);
        const int row = (mode == 0) ? (row_off + n) : (8 * (n >> 2) + (n & 3) + (mode == 2 ? 4 : 0));
        *(u32x4*)(WT + (size_t)row * ldk + koff + k0 + 8 * c) = o; }
    LDS_FENCE();
}
DEV void convert_weight(const float* W, int K, int N, bf16_t* WT, int ldk, int koff, int row_off, int mode, float* scr, int gw, int NGW, int lane, int& rot) {
    const int nblk = N / 32, items = (K / 64) * nblk;
    for (int it = (gw + NGW - (rot % NGW)) % NGW; it < items; it += NGW) transpose_item(W, N, WT, ldk, koff, row_off, mode, scr, it / nblk, it % nblk, lane);
    rot += items;
}
DEV void rms_row_bf16(const float* xrow, const float* g, bf16_t* orow, int lane) {
    f32x4 v[4]; float ss = 0.f;
#pragma unroll
    for (int j = 0; j < 4; ++j) { v[j] = *(const f32x4*)(xrow + (64 * j + lane) * 4); ss += (v[j][0] * v[j][0] + v[j][1] * v[j][1]) + (v[j][2] * v[j][2] + v[j][3] * v[j][3]); }
    const float rstd = rsqrtf(wave_sum(ss) * (1.f / 1024.f) + EPS);
#pragma unroll
    for (int j = 0; j < 4; ++j) { const f32x4 gg = *(const f32x4*)(g + (64 * j + lane) * 4);
        u32x2 o; o.x = pk2(v[j][0] * rstd * gg[0], v[j][1] * rstd * gg[1]); o.y = pk2(v[j][2] * rstd * gg[2], v[j][3] * rstd * gg[3]);
        *(u32x2*)(orow + (64 * j + lane) * 4) = o; }
}
DEV void rms_phase(const float* X, const float* g, bf16_t* H, int gw, int NGW, int lane, int T = ::T) {
    f32x4 gg[4];
#pragma unroll
    for (int j = 0; j < 4; ++j) gg[j] = *(const f32x4*)(g + (64 * j + lane) * 4);
    for (int t = gw; t < T; t += 2 * NGW) {
        const int t2 = t + NGW; const bool two = t2 < T; const int tb_ = two ? t2 : t;
        f32x4 v[4], u[4]; float sa = 0.f, sb = 0.f;
#pragma unroll
        for (int j = 0; j < 4; ++j) { v[j] = *(const f32x4*)(X + (size_t)t * 1024 + (64 * j + lane) * 4); u[j] = *(const f32x4*)(X + (size_t)tb_ * 1024 + (64 * j + lane) * 4); }
#pragma unroll
        for (int j = 0; j < 4; ++j) { sa += (v[j][0] * v[j][0] + v[j][1] * v[j][1]) + (v[j][2] * v[j][2] + v[j][3] * v[j][3]); sb += (u[j][0] * u[j][0] + u[j][1] * u[j][1]) + (u[j][2] * u[j][2] + u[j][3] * u[j][3]); }
#pragma unroll
        for (int o = 1; o < 64; o <<= 1) { sa += __shfl_xor(sa, o); sb += __shfl_xor(sb, o); }
        const float ra = rsqrtf(sa * (1.f / 1024.f) + EPS), rb = rsqrtf(sb * (1.f / 1024.f) + EPS);
#pragma unroll
        for (int j = 0; j < 4; ++j) { u32x2 o; o.x = pk2(v[j][0] * ra * gg[j][0], v[j][1] * ra * gg[j][1]); o.y = pk2(v[j][2] * ra * gg[j][2], v[j][3] * ra * gg[j][3]);
            *(u32x2*)(H + (size_t)t * 1024 + (64 * j + lane) * 4) = o; }
        if (two) {
#pragma unroll
            for (int j = 0; j < 4; ++j) { u32x2 o; o.x = pk2(u[j][0] * rb * gg[j][0], u[j][1] * rb * gg[j][1]); o.y = pk2(u[j][2] * rb * gg[j][2], u[j][3] * rb * gg[j][3]);
                *(u32x2*)(H + (size_t)tb_ * 1024 + (64 * j + lane) * 4) = o; } }
    }
}

DEV void phase0(const Params& p, unsigned char* ldsg, int gw, int NGW, int lane, int wave) {
    unsigned char* ws = p.ws; unsigned char* ob = (unsigned char*)p.out;
    float* scr = (float*)(ldsg + wave * 8448);
    int rot = 0;
    convert_weight(p.in[10], 1024, 1184, (bf16_t*)(ws + W_INAB), 1024, 0, 0, 0, scr, gw, NGW, lane, rot);
#pragma unroll 1
    for (int g = 0; g < 4; ++g) convert_weight(p.in[11] + g * 16384, 128, 128, (bf16_t*)(ws + W_POOL), 512, g * 128, g * 128, 0, scr, gw, NGW, lane, rot);
    convert_weight(p.in[14], 384, 768, (bf16_t*)(ws + W_UQ), 384, 0, 0, 0, scr, gw, NGW, lane, rot);
    convert_weight(p.in[16], 256, 512, (bf16_t*)(ws + W_UK), 256, 0, 0, 0, scr, gw, NGW, lane, rot);
    convert_weight(p.in[17], 256, 512, (bf16_t*)(ws + W_UV), 256, 0, 0, 0, scr, gw, NGW, lane, rot);
    const int gt = gw * 64 + lane, NGT = NGW * 64;
    const u32x4 z4 = {0u, 0u, 0u, 0u};
    for (int i = gt; i < 12288; i += NGT) *(u32x4*)(ws + W_INAB + (size_t)1184 * 2048 + (size_t)i * 16) = z4;
    for (int i = gt; i < 32768; i += NGT) { const int row = i >> 6, col = (i & 63) * 8; if ((row >> 7) != (col >> 7)) *(u32x4*)(ws + W_POOL + (size_t)i * 16) = z4; }
    { f32x4 gg[4];
#pragma unroll
      for (int j = 0; j < 4; ++j) gg[j] = *(const f32x4*)(p.in[7] + (64 * j + lane) * 4);
      bf16_t* H = (bf16_t*)(ws + H0);
      for (int t = gw; t < T; t += 2 * NGW) {
        const int t2 = t + NGW; const bool two = t2 < T; const int tb_ = two ? t2 : t;
        const float* xa = t < TPR ? p.in[0] + (size_t)t * 1024 : p.in[1] + (size_t)(t - TPR) * 1024;
        const float* xb = tb_ < TPR ? p.in[0] + (size_t)tb_ * 1024 : p.in[1] + (size_t)(tb_ - TPR) * 1024;
        f32x4 v[4], u[4]; float sa = 0.f, sb = 0.f;
#pragma unroll
        for (int j = 0; j < 4; ++j) { v[j] = *(const f32x4*)(xa + (64 * j + lane) * 4); u[j] = *(const f32x4*)(xb + (64 * j + lane) * 4); }
#pragma unroll
        for (int j = 0; j < 4; ++j) { sa += (v[j][0] * v[j][0] + v[j][1] * v[j][1]) + (v[j][2] * v[j][2] + v[j][3] * v[j][3]); sb += (u[j][0] * u[j][0] + u[j][1] * u[j][1]) + (u[j][2] * u[j][2] + u[j][3] * u[j][3]); }
#pragma unroll
        for (int o = 1; o < 64; o <<= 1) { sa += __shfl_xor(sa, o); sb += __shfl_xor(sb, o); }
        const float ra = rsqrtf(sa * (1.f / 1024.f) + EPS), rb = rsqrtf(sb * (1.f / 1024.f) + EPS);
#pragma unroll
        for (int j = 0; j < 4; ++j) { u32x2 o; o.x = pk2(v[j][0] * ra * gg[j][0], v[j][1] * ra * gg[j][1]); o.y = pk2(v[j][2] * ra * gg[j][2], v[j][3] * ra * gg[j][3]);
            *(u32x2*)(H + (size_t)t * 1024 + (64 * j + lane) * 4) = o; }
        if (two) {
#pragma unroll
            for (int j = 0; j < 4; ++j) { u32x2 o; o.x = pk2(u[j][0] * rb * gg[j][0], u[j][1] * rb * gg[j][1]); o.y = pk2(u[j][2] * rb * gg[j][2], u[j][3] * rb * gg[j][3]);
                *(u32x2*)(H + (size_t)tb_ * 1024 + (64 * j + lane) * 4) = o; } }
      } }
    bf16_t* ckv_all = (bf16_t*)(ob + D_CKVALL); bf16_t* kpe_all = (bf16_t*)(ob + D_KPEALL);
    for (int r0 = gw; r0 < 65536; r0 += 8 * NGW) {
        f32x4 v[8];
#pragma unroll
        for (int k = 0; k < 8; ++k) { const int r = r0 + k * NGW; v[k] = *(const f32x4*)(p.in[2] + (size_t)(r < 65536 ? r : r0) * 256 + lane * 4); }
#pragma unroll
        for (int k = 0; k < 8; ++k) { const int r = r0 + k * NGW; if (r < 65536) { const int b = r >> 12, j = r & 4095;
            u32x2 o; o.x = pk2(v[k][0], v[k][1]); o.y = pk2(v[k][2], v[k][3]); *(u32x2*)(ckv_all + (size_t)(TPR + b * SKV + j) * 256 + lane * 4) = o; } }
    }
    for (int i0 = gt; i0 < 65536 * 8; i0 += 4 * NGT) {
        f32x4 v[4];
#pragma unroll
        for (int k = 0; k < 4; ++k) { const int i = i0 + k * NGT; const int ii = i < 65536 * 8 ? i : i0; v[k] = *(const f32x4*)(p.in[3] + (size_t)(ii >> 3) * 32 + (ii & 7) * 4); }
#pragma unroll
        for (int k = 0; k < 4; ++k) { const int i = i0 + k * NGT; if (i < 65536 * 8) { const int r = i >> 3, c = (i & 7) * 4, b = r >> 12, j = r & 4095;
            u32x2 o; o.x = pk2(v[k][0], v[k][1]); o.y = pk2(v[k][2], v[k][3]); *(u32x2*)(kpe_all + (size_t)(TPR + b * SKV + j) * 32 + c) = o; } }
    }
    float* rope = (float*)(ob + D_ROPE);
    for (int i = gt; i < 16400 * 16; i += NGT) { const int pidx = i >> 4, k = i & 15; const int pos = pidx < TPR ? pidx : 4096 + (pidx - TPR);
        const float inv = powf(10000.0f, -(float)k / 16.0f); const float ang = (float)pos * inv;
        rope[pidx * 32 + k] = cosf(ang); rope[pidx * 32 + 16 + k] = sinf(ang); }
}

struct P2Loads { bf16x8 nb[16]; bf16x8 qraw, kvraw; float rx1, rx2, rcs, rsn; };
DEV void p2_load(const Params& p, int t, int lane, P2Loads& L) {
    const bf16_t* proj = (const bf16_t*)(p.ws + PROJ); const float* rope = (const float*)((unsigned char*)p.out + D_ROPE);
    const bool prm = t < TPR; const int r = t - TPR, b = prm ? 0 : (r >> 4), s = prm ? t : (r & 15);
    const bf16_t* pr = proj + (size_t)t * 1280;
    const bf16x8 z8 = {0, 0, 0, 0, 0, 0, 0, 0};
    const int c0 = lane * 8, w = 2 << (lane >> 4);
#pragma unroll
    for (int i = 0; i < 16; ++i) { const int sp = s - i;
        if (i >= w) L.nb[i] = z8;
        else if (sp >= 0) L.nb[i] = *(const bf16x8*)(pr - (size_t)i * 1280 + c0);
        else if (!prm) { const float* hp = p.in[4] + ((size_t)b * 15 + (15 + sp)) * 512 + c0; const f32x4 a = *(const f32x4*)hp, c = *(const f32x4*)(hp + 4);
            u32x4 q; q.x = pk2(a[0], a[1]); q.y = pk2(a[2], a[3]); q.z = pk2(c[0], c[1]); q.w = pk2(c[2], c[3]); L.nb[i] = __builtin_bit_cast(bf16x8, q); }
        else L.nb[i] = z8; }
    L.qraw = lane < 48 ? *(const bf16x8*)(pr + 512 + lane * 8) : z8;
    L.kvraw = lane < 32 ? *(const bf16x8*)(pr + 896 + lane * 8) : z8;
    const int l16 = lane & 15, pidx_ = prm ? t : TPR + s;
    L.rx1 = bf2f((short)pr[1152 + l16]); L.rx2 = bf2f((short)pr[1168 + l16]); L.rcs = rope[pidx_ * 32 + l16]; L.rsn = rope[pidx_ * 32 + 16 + l16];
}
DEV void phase2(const Params& p, int gw, int NGW, int lane) {
    unsigned char* ws = p.ws; unsigned char* ob = (unsigned char*)p.out; float* out = p.out;
    bf16_t* pooled = (bf16_t*)(ws + POOLED); bf16_t* qln = (bf16_t*)(ws + QLN);
    bf16_t* ckv_all = (bf16_t*)(ob + D_CKVALL); bf16_t* kpe_all = (bf16_t*)(ob + D_KPEALL);
    f32x4 gq0 = {0.f, 0.f, 0.f, 0.f}, gq1 = gq0, gk0 = gq0, gk1 = gq0;
    if (lane < 48) { gq0 = *(const f32x4*)(p.in[13] + lane * 8); gq1 = *(const f32x4*)(p.in[13] + lane * 8 + 4); }
    if (lane < 32) { gk0 = *(const f32x4*)(p.in[15] + lane * 8); gk1 = *(const f32x4*)(p.in[15] + lane * 8 + 4); }
    P2Loads L;
    if (gw < T) p2_load(p, gw, lane, L);
    for (int t = gw; t < T; t += NGW) {
        const bool prm = t < TPR; const int r = t - TPR, b = prm ? 0 : (r >> 4), s = prm ? t : (r & 15), pos = prm ? t : 4096 + s;
        const P2Loads C = L;
        if (t + NGW < T) p2_load(p, t + NGW, lane, L);
        {
            const int c0 = lane * 8, w = 2 << (lane >> 4);
            float sum[8], sf[8];
#pragma unroll
            for (int e = 0; e < 8; ++e) { sf[e] = bf2f(C.nb[0][e]); sum[e] = sf[e]; }
#pragma unroll
            for (int i = 1; i < 16; ++i)
#pragma unroll
                for (int e = 0; e < 8; ++e) sum[e] += bf2f(C.nb[i][e]);
            const float rc = 1.0f / (float)(pos + 1 < w ? pos + 1 : w);
            u32x4 o; o.x = pk2(sum[0] * rc - sf[0], sum[1] * rc - sf[1]); o.y = pk2(sum[2] * rc - sf[2], sum[3] * rc - sf[3]);
            o.z = pk2(sum[4] * rc - sf[4], sum[5] * rc - sf[5]); o.w = pk2(sum[6] * rc - sf[6], sum[7] * rc - sf[7]);
            *(u32x4*)(pooled + (size_t)t * 512 + c0) = o;
            float* np = nullptr;
            if (prm) { if (t >= TPR - 15) np = out + O_POOLP + (size_t)(t - (TPR - 15)) * 512 + c0; }
            else if (s >= 1) np = out + O_POOLS + ((size_t)b * 15 + (s - 1)) * 512 + c0;
            if (np) { *(f32x4*)np = (f32x4){sf[0], sf[1], sf[2], sf[3]}; *(f32x4*)(np + 4) = (f32x4){sf[4], sf[5], sf[6], sf[7]}; }
        }
        float vq[8], vk[8]; float sq = 0.f, sk = 0.f;
#pragma unroll
        for (int e = 0; e < 8; ++e) { vq[e] = bf2f(C.qraw[e]); sq += vq[e] * vq[e]; vk[e] = bf2f(C.kvraw[e]); sk += vk[e] * vk[e]; }
#pragma unroll
        for (int o = 1; o < 64; o <<= 1) { sq += __shfl_xor(sq, o); sk += __shfl_xor(sk, o); }
        const float rq = rsqrtf(sq * (1.f / 384.f) + EPS), rk = rsqrtf(sk * (1.f / 256.f) + EPS);
        if (lane < 48) {
            u32x4 o; o.x = pk2(vq[0] * rq * gq0[0], vq[1] * rq * gq0[1]); o.y = pk2(vq[2] * rq * gq0[2], vq[3] * rq * gq0[3]);
            o.z = pk2(vq[4] * rq * gq1[0], vq[5] * rq * gq1[1]); o.w = pk2(vq[6] * rq * gq1[2], vq[7] * rq * gq1[3]);
            *(u32x4*)(qln + (size_t)t * 384 + lane * 8) = o; }
        const size_t krow = prm ? (size_t)t : (size_t)(TPR + b * SKV + 4096 + s);
        if (lane < 32) {
            f32x4 o0 = {vk[0] * rk * gk0[0], vk[1] * rk * gk0[1], vk[2] * rk * gk0[2], vk[3] * rk * gk0[3]};
            f32x4 o1 = {vk[4] * rk * gk1[0], vk[5] * rk * gk1[1], vk[6] * rk * gk1[2], vk[7] * rk * gk1[3]};
            float* op = (prm ? out + O_CKVP + (size_t)t * 256 : out + O_CKVS + (size_t)r * 256) + lane * 8;
            *(f32x4*)op = o0; *(f32x4*)(op + 4) = o1;
            u32x4 o; o.x = pk2(o0[0], o0[1]); o.y = pk2(o0[2], o0[3]); o.z = pk2(o1[0], o1[1]); o.w = pk2(o1[2], o1[3]);
            *(u32x4*)(ckv_all + krow * 256 + lane * 8) = o; }
        if (lane < 16) {
            const float x1 = C.rx1, x2 = C.rx2, cs = C.rcs, sn = C.rsn;
            const float o1 = x1 * cs - x2 * sn, o2 = x2 * cs + x1 * sn;
            float* op = prm ? out + O_KPEP + (size_t)t * 32 : out + O_KPES + (size_t)r * 32;
            op[lane] = o1; op[16 + lane] = o2;
            kpe_all[krow * 32 + lane] = (bf16_t)(pk2(o1, 0.f) & 0xffffu); kpe_all[krow * 32 + 16 + lane] = (bf16_t)(pk2(o2, 0.f) & 0xffffu);
        }
    }
}

struct AttnPtrs { const bf16_t* Q; const bf16_t* KN; const bf16_t* KPE; const bf16_t* VT; const float* rope; bf16_t* cat; };

DEV void load_q(const AttnPtrs& A, size_t trow, int h, int pidx, int hi, bf16x8 (&qf)[6]) {
    const bf16_t* qp = A.Q + trow * 768 + h * 96 + hi * 8;
#pragma unroll
    for (int ks = 0; ks < 6; ++ks) qf[ks] = *(const bf16x8*)(qp + ks * 16);
    const float* rp = A.rope + pidx * 32 + hi * 8;
    const f32x4 c0 = *(const f32x4*)rp, c1 = *(const f32x4*)(rp + 4), s0 = *(const f32x4*)(rp + 16), s1 = *(const f32x4*)(rp + 20);
    float x1[8], x2[8], o1[8], o2[8];
#pragma unroll
    for (int j = 0; j < 8; ++j) { x1[j] = bf2f(qf[4][j]); x2[j] = bf2f(qf[5][j]); const float cs = j < 4 ? c0[j & 3] : c1[j & 3], sn = j < 4 ? s0[j & 3] : s1[j & 3];
        o1[j] = (x1[j] * cs - x2[j] * sn) * QSCALE; o2[j] = (x2[j] * cs + x1[j] * sn) * QSCALE; }
    u32x4 a, b; a.x = pk2(o1[0], o1[1]); a.y = pk2(o1[2], o1[3]); a.z = pk2(o1[4], o1[5]); a.w = pk2(o1[6], o1[7]);
    b.x = pk2(o2[0], o2[1]); b.y = pk2(o2[2], o2[3]); b.z = pk2(o2[4], o2[5]); b.w = pk2(o2[6], o2[7]);
    qf[4] = __builtin_bit_cast(bf16x8, a); qf[5] = __builtin_bit_cast(bf16x8, b);
#pragma unroll
    for (int ks = 0; ks < 4; ++ks) { u32x4 w;
        w.x = pk2(bf2f(qf[ks][0]) * QSCALE, bf2f(qf[ks][1]) * QSCALE); w.y = pk2(bf2f(qf[ks][2]) * QSCALE, bf2f(qf[ks][3]) * QSCALE);
        w.z = pk2(bf2f(qf[ks][4]) * QSCALE, bf2f(qf[ks][5]) * QSCALE); w.w = pk2(bf2f(qf[ks][6]) * QSCALE, bf2f(qf[ks][7]) * QSCALE);
        qf[ks] = __builtin_bit_cast(bf16x8, w); }
}
DEV void softmax_update(f32x16 (&s)[2], float& m, float& l, f32x16 (&o)[2]) {
    float mx = s[0][0];
#pragma unroll
    for (int i = 1; i < 16; ++i) mx = fmaxf(mx, s[0][i]);
#pragma unroll
    for (int i = 0; i < 16; ++i) mx = fmaxf(mx, s[1][i]);
    mx = fmaxf(mx, __shfl_xor(mx, 32));
    if (__any(mx - m > 8.0f)) {
        const float mn = fmaxf(m, mx), alpha = __builtin_amdgcn_exp2f(m - mn);
        m = mn; l *= alpha; o[0] *= alpha; o[1] *= alpha;
    }
    float sum = 0.f;
#pragma unroll
    for (int i = 0; i < 16; ++i) { s[0][i] = __builtin_amdgcn_exp2f(s[0][i] - m); s[1][i] = __builtin_amdgcn_exp2f(s[1][i] - m); sum += s[0][i] + s[1][i]; }
    l += sum;
}

constexpr int KS_STRIDE = 104, VS_STRIDE = 68, KS_BYTES = 64 * KS_STRIDE * 2, VS_BYTES = 64 * VS_STRIDE * 2;

DEV void attn_qk(const bf16_t* K, const bf16x8 (&qf)[6], int l32, int hi, f32x16 (&s)[2]) {
    bf16x8 kf[6][2];
#pragma unroll
    for (int ks = 0; ks < 6; ++ks)
#pragma unroll
        for (int st = 0; st < 2; ++st) kf[ks][st] = *(const bf16x8*)(K + (32 * st + l32) * KS_STRIDE + 16 * ks + hi * 8);
    __builtin_amdgcn_sched_barrier(0);
    s[0] = zero16(); s[1] = zero16();
#pragma unroll
    for (int ks = 0; ks < 6; ++ks)
#pragma unroll
        for (int st = 0; st < 2; ++st) s[st] = mfma32(kf[ks][st], qf[ks], s[st]);
}
DEV void attn_pv(const bf16_t* V, const f32x16 (&s)[2], int l32, int hi, f32x16 (&o)[2]) {
    bf16x8 vf[4][2];
#pragma unroll
    for (int ks = 0; ks < 4; ++ks)
#pragma unroll
        for (int dt = 0; dt < 2; ++dt) { const bf16_t* vp = V + (32 * dt + l32) * VS_STRIDE + 16 * ks + hi * 4; vf[ks][dt] = cat4(*(const s16x4*)vp, *(const s16x4*)(vp + 8)); }
    bf16x8 pb[4]; pb[0] = pack8<0>(s[0]); pb[1] = pack8<8>(s[0]); pb[2] = pack8<0>(s[1]); pb[3] = pack8<8>(s[1]);
    __builtin_amdgcn_sched_barrier(0);
#pragma unroll
    for (int ks = 0; ks < 4; ++ks)
#pragma unroll
        for (int dt = 0; dt < 2; ++dt) o[dt] = mfma32(vf[ks][dt], pb[ks], o[dt]);
}
constexpr int VS2_STRIDE = 132, K2_TILE = 128 * KS_STRIDE, V2_TILE = 64 * VS2_STRIDE;
DEV void attn_pv2(const bf16_t* V, const f32x16 (&s)[2], int l32, int hi, f32x16 (&o)[2]) {
    bf16x8 vf[4][2];
#pragma unroll
    for (int ks = 0; ks < 4; ++ks)
#pragma unroll
        for (int dt = 0; dt < 2; ++dt) { const bf16_t* vp = V + (32 * dt + l32) * VS2_STRIDE + 16 * ks + hi * 4; vf[ks][dt] = cat4(*(const s16x4*)vp, *(const s16x4*)(vp + 8)); }
    bf16x8 pb[4]; pb[0] = pack8<0>(s[0]); pb[1] = pack8<8>(s[0]); pb[2] = pack8<0>(s[1]); pb[3] = pack8<8>(s[1]);
    __builtin_amdgcn_sched_barrier(0);
#pragma unroll
    for (int ks = 0; ks < 4; ++ks)
#pragma unroll
        for (int dt = 0; dt < 2; ++dt) o[dt] = mfma32(vf[ks][dt], pb[ks], o[dt]);
}
DEV void attn_prompt_unit(const AttnPtrs& A, unsigned char* ldsg, int h, int qb) {
    const int tid = otid(), lane = tid & 63, w = tid >> 6, l32 = lane & 31, hi = lane >> 5;
    const int qrow = qb * 256 + w * 32 + l32;
    bf16x8 qf[6]; load_q(A, (size_t)qrow, h, qrow, hi, qf);
    f32x16 o[2]; o[0] = zero16(); o[1] = zero16(); float m = -1e30f, l = 0.f;
    const int nt2 = 2 * qb + 2, wlim = 4 * qb + (w >> 1);
    bf16_t* Ks = (bf16_t*)ldsg; bf16_t* Vs = (bf16_t*)(ldsg + 3 * K2_TILE * 2);
    const int skey = tid >> 3, sc = tid & 7, rkey = tid >> 2, rc = tid & 3, vd = tid >> 4, vc = tid & 15;
    const bf16_t* kn_src = A.KN + (size_t)skey * 512 + h * 64 + sc * 8;
    const bf16_t* kr_src = A.KPE + (size_t)rkey * 32 + rc * 8;
    const bf16_t* v_src = A.VT + (size_t)(h * 64 + vd) * NK + vc * 8;
    const int kdst = skey * KS_STRIDE + sc * 8, rdst = rkey * KS_STRIDE + 64 + rc * 8, vdst = vd * VS2_STRIDE + vc * 8;
#define ST_K(buf, a, b, c) do { bf16_t* K_ = Ks + (buf) * K2_TILE; *(u32x4*)(K_ + kdst) = (a); *(u32x4*)(K_ + kdst + 64 * KS_STRIDE) = (b); *(u32x4*)(K_ + rdst) = (c); } while (0)
#define ST_V(buf, a, b) do { bf16_t* V_ = Vs + (buf) * V2_TILE; *(u32x2*)(V_ + vdst) = (u32x2){(a).x, (a).y}; *(u32x2*)(V_ + vdst + 4) = (u32x2){(a).z, (a).w}; \
        *(u32x2*)(V_ + vdst + 32 * VS2_STRIDE) = (u32x2){(b).x, (b).y}; *(u32x2*)(V_ + vdst + 32 * VS2_STRIDE + 4) = (u32x2){(b).z, (b).w}; } while (0)
    {
        u32x4 a = *(const u32x4*)kn_src, b = *(const u32x4*)(kn_src + 64 * 512), c = *(const u32x4*)kr_src;
        u32x4 d = *(const u32x4*)(kn_src + 128 * 512), e = *(const u32x4*)(kn_src + 192 * 512), f = *(const u32x4*)(kr_src + 128 * 32);
        u32x4 g = *(const u32x4*)v_src, hh = *(const u32x4*)(v_src + (size_t)32 * NK);
        ST_K(0, a, b, c); ST_K(1, d, e, f); ST_V(0, g, hh);
    }
    __syncthreads();
    f32x16 s[2]; attn_qk(Ks, qf, l32, hi, s);
    int k3 = 0;
    for (int kt = 0; kt < nt2; ++kt) {
        const int k3n = k3 == 2 ? 0 : k3 + 1, k3nn = k3n == 2 ? 0 : k3n + 1;
        u32x4 rk0, rk1, rr, rv0, rv1;
        const bool pk_ = kt + 2 < nt2, pv_ = kt + 1 < nt2;
        if (pk_) { const size_t k0 = (size_t)(kt + 2) * 128; rk0 = *(const u32x4*)(kn_src + k0 * 512); rk1 = *(const u32x4*)(kn_src + (k0 + 64) * 512); rr = *(const u32x4*)(kr_src + k0 * 32); }
        if (pv_) { const size_t k0 = (size_t)(kt + 1) * 128; rv0 = *(const u32x4*)(v_src + k0); rv1 = *(const u32x4*)(v_src + (size_t)32 * NK + k0); }
#pragma unroll
        for (int j = 0; j < 2; ++j) {
            if (2 * kt + j <= wlim) {
                const bf16_t* Kn = (j == 0) ? Ks + k3 * K2_TILE + 64 * KS_STRIDE : Ks + k3n * K2_TILE;
                const bf16_t* V = Vs + (kt & 1) * V2_TILE + 64 * j;
                f32x16 sn[2];
                if (w < 4) {
                    attn_qk(Kn, qf, l32, hi, sn);
                    __builtin_amdgcn_sched_barrier(0);
                    softmax_update(s, m, l, o);
                    attn_pv2(V, s, l32, hi, o);
                } else {
                    softmax_update(s, m, l, o);
                    attn_pv2(V, s, l32, hi, o);
                    __builtin_amdgcn_sched_barrier(0);
                    attn_qk(Kn, qf, l32, hi, sn);
                }
                s[0] = sn[0]; s[1] = sn[1];
            }
        }
        if (pk_) ST_K(k3nn, rk0, rk1, rr);
        if (pv_) ST_V((kt + 1) & 1, rv0, rv1);
        __syncthreads();
        k3 = k3n;
    }
#undef ST_K
#undef ST_V
    const float lt = l + __shfl_xor(l, 32), rl = 1.0f / lt;
    bf16_t* op = A.cat + (size_t)qrow * 1024 + 512 + h * 64 + 4 * hi;
#pragma unroll
    for (int dt = 0; dt < 2; ++dt)
#pragma unroll
        for (int g = 0; g < 4; ++g) { u32x2 v; v.x = pk2(o[dt][4 * g] * rl, o[dt][4 * g + 1] * rl); v.y = pk2(o[dt][4 * g + 2] * rl, o[dt][4 * g + 3] * rl);
            *(u32x2*)(op + 32 * dt + 8 * g) = v; }
}

DEV void attn_sample_unit(const AttnPtrs& A, unsigned char* ldsg, int b, int h) {
    const int tid = otid(), lane = tid & 63, w = tid >> 6, l32 = lane & 31, hi = lane >> 5;
    const int s_ = l32 < 16 ? l32 : 15;
    bf16x8 qf[6]; load_q(A, (size_t)(TPR + b * 16 + s_), h, TPR + s_, hi, qf);
    f32x16 o[2]; o[0] = zero16(); o[1] = zero16(); float m = -1e30f, l = 0.f;
    const size_t base = (size_t)TPR + (size_t)b * SKV;
    bf16x8 kn[2][6];
#define SA_LOADK(dst, kt_) do { _Pragma("unroll") for (int st = 0; st < 2; ++st) { int key = (kt_) * 64 + 32 * st + l32; key = key < SKV ? key : SKV - 1; const size_t row = base + key; \
        const bf16_t* kp = A.KN + row * 512 + h * 64 + hi * 8; const bf16_t* rp = A.KPE + row * 32 + hi * 8; \
        _Pragma("unroll") for (int ks = 0; ks < 4; ++ks) dst[st][ks] = *(const bf16x8*)(kp + 16 * ks); \
        _Pragma("unroll") for (int ks = 0; ks < 2; ++ks) dst[st][4 + ks] = *(const bf16x8*)(rp + 16 * ks); } } while (0)
    SA_LOADK(kn, w);
    for (int kt = w; kt < 65; kt += 8) {
        bf16x8 kf[2][6];
#pragma unroll
        for (int st = 0; st < 2; ++st)
#pragma unroll
            for (int ks = 0; ks < 6; ++ks) kf[st][ks] = kn[st][ks];
        bf16x8 vf[4][2];
#pragma unroll
        for (int ks = 0; ks < 4; ++ks)
#pragma unroll
            for (int dt = 0; dt < 2; ++dt) { const bf16_t* vp = A.VT + (size_t)(h * 64 + 32 * dt + l32) * NK + base + kt * 64 + 16 * ks + hi * 4; vf[ks][dt] = cat4(*(const s16x4*)vp, *(const s16x4*)(vp + 8)); }
        if (kt + 8 < 65) SA_LOADK(kn, kt + 8);
        f32x16 s[2]; s[0] = zero16(); s[1] = zero16();
#pragma unroll
        for (int ks = 0; ks < 6; ++ks)
#pragma unroll
            for (int st = 0; st < 2; ++st) s[st] = mfma32(kf[st][ks], qf[ks], s[st]);
        if (kt == 64) {
#pragma unroll
            for (int st = 0; st < 2; ++st)
#pragma unroll
                for (int i = 0; i < 16; ++i) { const int key = 4096 + 32 * st + 8 * (i >> 2) + 4 * hi + (i & 3); if (key >= SKV) s[st][i] = -1e30f; }
        }
        softmax_update(s, m, l, o);
        bf16x8 pb[4]; pb[0] = pack8<0>(s[0]); pb[1] = pack8<8>(s[0]); pb[2] = pack8<0>(s[1]); pb[3] = pack8<8>(s[1]);
#pragma unroll
        for (int ks = 0; ks < 4; ++ks)
#pragma unroll
            for (int dt = 0; dt < 2; ++dt) o[dt] = mfma32(vf[ks][dt], pb[ks], o[dt]);
    }
#undef SA_LOADK
    float* cm = (float*)ldsg; float* cl = cm + 256; float* cO = cl + 256;
    const float lt = l + __shfl_xor(l, 32);
    if (hi == 0) { cm[w * 32 + l32] = m; cl[w * 32 + l32] = lt; }
#pragma unroll
    for (int dt = 0; dt < 2; ++dt)
#pragma unroll
        for (int i = 0; i < 16; ++i) cO[(w * 64 + 32 * dt + 8 * (i >> 2) + 4 * hi + (i & 3)) * 32 + l32] = o[dt][i];
    __syncthreads();
    for (int idx = tid; idx < 1024; idx += 512) { const int q = idx & 15, d = idx >> 4;
        float M = cm[q];
#pragma unroll
        for (int ww = 1; ww < 8; ++ww) M = fmaxf(M, cm[ww * 32 + q]);
        float num = 0.f, den = 0.f;
#pragma unroll
        for (int ww = 0; ww < 8; ++ww) { const float f = __builtin_amdgcn_exp2f(cm[ww * 32 + q] - M); num += cO[(ww * 64 + d) * 32 + q] * f; den += cl[ww * 32 + q] * f; }
        A.cat[(size_t)(TPR + b * 16 + q) * 1024 + 512 + h * 64 + d] = (bf16_t)(pk2(num / den, 0.f) & 0xffffu); }
    __syncthreads();
}

template <bool IS_X>
DEV void conv_load(const Params& p, int tid, int tt, int ct, bf16x8 (&xr)[4][4]) {
    const int ti = tid >> 3, cg8 = tid & 7, t = tt * 64 + ti, ld = IS_X ? 2048 : 1024;
    const bf16_t* raw = (const bf16_t*)(p.ws + (IS_X ? XRAW : BCRAW));
    const bool prm = t < TPR; const int r = t - TPR, b = prm ? 0 : (r >> 4), s = prm ? t : (r & 15);
    const bf16x8 z8 = {0, 0, 0, 0, 0, 0, 0, 0};
#pragma unroll
    for (int q = 0; q < 4; ++q) {
        const int cc = ct * 256 + q * 64 + cg8 * 8, ch = IS_X ? cc : 2048 + cc;
#pragma unroll
        for (int j = 0; j < 4; ++j) {
            const int sp = s - 3 + j;
            if (sp >= 0) xr[q][j] = *(const bf16x8*)(raw + (size_t)(t - 3 + j) * ld + cc);
            else if (!prm) { const float* hp = p.in[5] + ((size_t)b * 3 + (3 + sp)) * 3072 + ch; const f32x4 a = *(const f32x4*)hp, c = *(const f32x4*)(hp + 4);
                u32x4 w; w.x = pk2(a[0], a[1]); w.y = pk2(a[2], a[3]); w.z = pk2(c[0], c[1]); w.w = pk2(c[2], c[3]); xr[q][j] = __builtin_bit_cast(bf16x8, w); }
            else xr[q][j] = z8;
        }
    }
}
template <bool IS_X>
DEV void conv_phase(const Params& p, unsigned char* ldsg, int bid, int G, int unit = -1) {
    constexpr int NCT = IS_X ? 8 : 4, NITEMS = 260 * NCT;
    unsigned char* ws = p.ws; float* out = p.out;
    const int tid = otid(), ti = tid >> 3, cg8 = tid & 7;
    bf16_t* tile = (bf16_t*)ldsg;
    bf16x8 xr[4][4];
    const bool um = unit >= 0, uprm = unit < 256;
    const int uc = unit >> 2, ug = unit & 3, ub = (unit - 256) >> 2;
    const int nit = um ? (uprm ? 8 : 2) : (bid < NITEMS ? (NITEMS - 1 - bid) / G + 1 : 0);
#define CONV_MAP(k, tt_, ct_) do { if (um) { if (uprm) { tt_ = 4 * uc + ((k) >> 1); ct_ = 2 * ug + ((k) & 1); } else { tt_ = 256 + (ub >> 2); ct_ = 2 * ug + (k); } } \
        else { const int it_ = bid + (k) * G; tt_ = it_ / NCT; ct_ = it_ % NCT; } } while (0)
    if (nit > 0) { int tt0, ct0; CONV_MAP(0, tt0, ct0); conv_load<IS_X>(p, tid, tt0, ct0, xr); }
    for (int k = 0; k < nit; ++k) {
        int tt, ct; CONV_MAP(k, tt, ct);
        const int t = tt * 64 + ti;
        const bool prm = t < TPR; const int r = t - TPR, b = prm ? 0 : (r >> 4), s = prm ? t : (r & 15);
        const bool is_c = !IS_X && ct >= 2;
        u32x4 ov[4]; bf16x8 lastrow[4];
#pragma unroll
        for (int q = 0; q < 4; ++q) {
            const int cc = ct * 256 + q * 64 + cg8 * 8, ch = IS_X ? cc : 2048 + cc;
            float acc[8];
            { const f32x4 b0 = *(const f32x4*)(p.in[21] + ch), b1 = *(const f32x4*)(p.in[21] + ch + 4);
#pragma unroll
              for (int e = 0; e < 4; ++e) { acc[e] = b0[e]; acc[4 + e] = b1[e]; } }
#pragma unroll
            for (int j = 0; j < 4; ++j) {
                const f32x4 w0 = *(const f32x4*)(p.in[20] + j * 3072 + ch), w1 = *(const f32x4*)(p.in[20] + j * 3072 + ch + 4);
#pragma unroll
                for (int e = 0; e < 4; ++e) { acc[e] += w0[e] * bf2f(xr[q][j][e]); acc[4 + e] += w1[e] * bf2f(xr[q][j][4 + e]); }
            }
            lastrow[q] = xr[q][3];
            float y[8];
#pragma unroll
            for (int e = 0; e < 8; ++e) y[e] = silu(acc[e]);
            ov[q].x = pk2(y[0], y[1]); ov[q].y = pk2(y[2], y[3]); ov[q].z = pk2(y[4], y[5]); ov[q].w = pk2(y[6], y[7]);
            if (!is_c) { const bf16x8 o8 = __builtin_bit_cast(bf16x8, ov[q]);
                const int tk = ti & 15, pos = ((((tk >> 2) & 1) * 2 + (tk >> 3)) << 2) + (tk & 3);
                const int rowb = IS_X ? ((q * 4 + (ti >> 4)) * 64 + cg8 * 8) : (((q >> 1) * 4 + (ti >> 4)) * 128 + (q & 1) * 64 + cg8 * 8);
#pragma unroll
                for (int e = 0; e < 8; ++e) tile[(rowb + e) * 16 + pos] = (bf16_t)o8[e]; }
        }
        if (k + 1 < nit) { int tn, cn; CONV_MAP(k + 1, tn, cn); conv_load<IS_X>(p, tid, tn, cn, xr); }
#pragma unroll
        for (int q = 0; q < 4; ++q) {
            const int cc = ct * 256 + q * 64 + cg8 * 8, ch = IS_X ? cc : 2048 + cc;
            if (!IS_X) { if (!is_c) *(u32x4*)((bf16_t*)(ws + BN) + (size_t)t * 512 + cc) = ov[q]; else *(u32x4*)((bf16_t*)(ws + CN) + (size_t)t * 512 + (cc - 512)) = ov[q]; }
            float* np = nullptr;
            if (prm) { if (t >= TPR - 3) np = out + O_CONVP + (size_t)(t - (TPR - 3)) * 3072 + ch; }
            else if (s >= 13) np = out + O_CONVS + ((size_t)b * 3 + (s - 13)) * 3072 + ch;
            if (np) { const bf16x8 l8 = lastrow[q]; *(f32x4*)np = (f32x4){bf2f(l8[0]), bf2f(l8[1]), bf2f(l8[2]), bf2f(l8[3])}; *(f32x4*)(np + 4) = (f32x4){bf2f(l8[4]), bf2f(l8[5]), bf2f(l8[6]), bf2f(l8[7])}; }
        }
        if (!is_c) {
            __syncthreads();
            if (IS_X) {
#pragma unroll
                for (int q = 0; q < 4; ++q) { const u32x4 tv = *(const u32x4*)(tile + q * 4096 + tid * 8);
                    *(u32x4*)((bf16_t*)(ws + XTB) + ((size_t)(ct * 4 + q) * NTB + tt * 4) * 1024 + tid * 8) = tv; }
            } else {
#pragma unroll
                for (int q = 0; q < 4; ++q) { const int g2 = q >> 1, cidx = (q & 1) * 512 + tid; const u32x4 tv = *(const u32x4*)(tile + g2 * 8192 + cidx * 8);
                    *(u32x4*)((bf16_t*)(ws + BTB) + ((size_t)(ct * 2 + g2) * NTB + tt * 4) * 2048 + cidx * 8) = tv; }
            }
            __syncthreads();
        }
    }
#undef CONV_MAP
}

struct SsdUnit { int t0, L, g, c, b; bool prm; };
DEV SsdUnit ssd_unit(int u) { SsdUnit U; if (u < 256) { U.prm = true; U.c = u >> 2; U.g = u & 3; U.t0 = U.c * 256; U.L = 256; U.b = 0; } else { const int su = u - 256; U.prm = false; U.b = su >> 2; U.g = su & 3; U.c = 0; U.t0 = TPR + U.b * 16; U.L = 16; } return U; }
DEV float ssd_tables(const float* DT, const SsdUnit& U, int hd, float a, float* dtv, float* acv, int lane) {
    float run = 0.f; const int nseg = (U.L + 63) >> 6;
    float dts[4];
#pragma unroll
    for (int sg = 0; sg < 4; ++sg) { const int j = sg * 64 + lane; dts[sg] = (j < U.L) ? DT[(size_t)(U.t0 + j) * 32 + hd] : 0.f; }
#pragma unroll
    for (int sg = 0; sg < 4; ++sg) { if (sg >= nseg) break; const int j = sg * 64 + lane;
        const float dt = dts[sg]; float v = dt * a;
#pragma unroll
        for (int o = 1; o < 64; o <<= 1) { const float uu = __shfl_up(v, o); if (lane >= o) v += uu; }
        v += run; dtv[j] = dt; acv[j] = v; run = __shfl(v, 63); }
    LDS_FENCE();
    return run;
}
DEV void ssd_s1_unit(const Params& p, unsigned char* ldsg, int u) {
    unsigned char* ws = p.ws;
    const int tid = otid(), lane = tid & 63, w = tid >> 6, l32 = lane & 31, hi = lane >> 5;
    const SsdUnit U = ssd_unit(u); const int hd = U.g * 8 + w;
    float* dtv = (float*)(ldsg + w * 3072); float* acv = dtv + 256; float* wv = acv + 256;
    const float a = -__expf(p.in[23][hd]);
    const float last = ssd_tables((const float*)(ws + DTB), U, hd, a, dtv, acv, lane);
    const int npad = U.prm ? 256 : 64;
    for (int j = lane; j < npad; j += 64) wv[j] = __expf(last - acv[j]) * dtv[j];
    LDS_FENCE();
    const bf16_t* XT = (const bf16_t*)(ws + XTB); const bf16_t* BT = (const bf16_t*)(ws + BTB);
    const int nks = (U.L + 15) >> 4;
    const float dl = __expf(last);
    if (U.prm && lane == 0) ((float*)(ws + DEC))[U.c * 32 + hd] = dl;
#pragma unroll 1
    for (int nh = 0; nh < 2; ++nh) {
        f32x16 acc[2][2];
#pragma unroll
        for (int a_ = 0; a_ < 2; ++a_)
#pragma unroll
            for (int b_ = 0; b_ < 2; ++b_) acc[a_][b_] = zero16();
#pragma unroll 4
        for (int ks = 0; ks < nks; ++ks) {
            const f32x4 w0 = *(const f32x4*)(wv + 16 * ks + 4 * hi), w1 = *(const f32x4*)(wv + 16 * ks + 8 + 4 * hi); const size_t tb = (size_t)(U.t0 >> 4) + ks;
            bf16x8 xa[2], bb[2];
#pragma unroll
            for (int pt = 0; pt < 2; ++pt) { const bf16x8 x = *(const bf16x8*)(XT + (((size_t)hd * NTB + tb) * 64 + 32 * pt + l32) * 16 + hi * 8);
                u32x4 q; q.x = pk2(bf2f(x[0]) * w0[0], bf2f(x[1]) * w0[1]); q.y = pk2(bf2f(x[2]) * w0[2], bf2f(x[3]) * w0[3]);
                q.z = pk2(bf2f(x[4]) * w1[0], bf2f(x[5]) * w1[1]); q.w = pk2(bf2f(x[6]) * w1[2], bf2f(x[7]) * w1[3]); xa[pt] = __builtin_bit_cast(bf16x8, q); }
#pragma unroll
            for (int nt = 0; nt < 2; ++nt) bb[nt] = *(const bf16x8*)(BT + (((size_t)U.g * NTB + tb) * 128 + 64 * nh + 32 * nt + l32) * 16 + hi * 8);
#pragma unroll
            for (int pt = 0; pt < 2; ++pt)
#pragma unroll
                for (int nt = 0; nt < 2; ++nt) acc[pt][nt] = mfma32(xa[pt], bb[nt], acc[pt][nt]);
        }
        {
            const size_t eo = (size_t)(4 * hi) * 128 + 64 * nh + l32;
            float* sp = U.prm ? (float*)(ws + STATES) + ((size_t)U.c * 32 + hd) * 8192 + eo : p.out + O_SSMS + ((size_t)U.b * 32 + hd) * 8192 + eo;
            const float* hp = U.prm ? sp : p.in[6] + ((size_t)U.b * 32 + hd) * 8192 + eo;
            const float dmul = U.prm ? 0.f : dl;
#pragma unroll
            for (int pt = 0; pt < 2; ++pt)
#pragma unroll
                for (int g4 = 0; g4 < 4; ++g4) {
                    float* q = sp + (32 * pt + 8 * g4) * 128; const float* hq = hp + (32 * pt + 8 * g4) * 128;
                    asm volatile("" : "+v"(q), "+v"(hq));
#pragma unroll
                    for (int e = 0; e < 4; ++e)
#pragma unroll
                        for (int nt = 0; nt < 2; ++nt) { float v = acc[pt][nt][4 * g4 + e]; if (!U.prm) v += hq[e * 128 + 32 * nt] * dmul; q[e * 128 + 32 * nt] = v; }
                    asm volatile("" ::: "memory");
                }
        }
    }
}
DEV void ssd_s2(const Params& p, int G) {
    float* ST = (float*)(p.ws + STATES); const float* dec = (const float*)(p.ws + DEC);
    for (int e = blockIdx.x * 512 + threadIdx.x; e < 262144; e += G * 512) { const int hd = e >> 13; float run = 0.f;
        for (int c0 = 0; c0 < 64; c0 += 8) {
            float sv[8], dv[8];
#pragma unroll
            for (int k = 0; k < 8; ++k) { sv[k] = ST[(size_t)(c0 + k) * 262144 + e]; dv[k] = dec[(c0 + k) * 32 + hd]; }
#pragma unroll
            for (int k = 0; k < 8; ++k) { ST[(size_t)(c0 + k) * 262144 + e] = run; run = run * dv[k] + sv[k]; }
        }
        p.out[O_SSMP + e] = run; }
}
template <bool dummy>
DEV void ssd_s3_unit(const Params& p, unsigned char* ldsg, int u) {
    unsigned char* ws = p.ws;
    const int tid = otid(), lane = tid & 63, w = tid >> 6, l32 = lane & 31, hi = lane >> 5;
    const SsdUnit U = ssd_unit(u); const int hd = U.g * 8 + w;
    const bf16_t* Bl = (const bf16_t*)ldsg; const bf16_t* Cl = (const bf16_t*)(ldsg + 65536);
    float* dtv = (float*)(ldsg + 131072 + 64 + w * 2048); float* acv = dtv + 256;
    float* red = (float*)(ldsg + 131072 + 64 + 16384);
    const bf16_t* XT = (const bf16_t*)(ws + XTB); const bf16_t* BNp = (const bf16_t*)(ws + BN); const bf16_t* CNp = (const bf16_t*)(ws + CN);
    { const int nrows = U.prm ? 256 : 32;
      u32x4 vb[8], vc[8];
#pragma unroll
      for (int k = 0; k < 8; ++k) { const int q = tid + 512 * k; if (q < nrows * 16) { const int row = q >> 4, ch = q & 15; const size_t go = ((size_t)U.t0 + row) * 512 + U.g * 128 + ch * 8;
          vb[k] = *(const u32x4*)(BNp + go); vc[k] = *(const u32x4*)(CNp + go); } }
#pragma unroll
      for (int k = 0; k < 8; ++k) { const int q = tid + 512 * k; if (q < nrows * 16) { const int row = q >> 4, ch = q & 15; const int lo = row * 256 + ((ch ^ (row & 15)) << 4);
          *(u32x4*)(ldsg + lo) = vb[k]; *(u32x4*)(ldsg + 65536 + lo) = vc[k]; } } }
    const float a = -__expf(p.in[23][hd]);
    (void)ssd_tables((const float*)(ws + DTB), U, hd, a, dtv, acv, lane);
    float* fv = (float*)(ldsg + 131072 + 64 + 16384 + 2048 + w * 1024);
    for (int j = lane; j < 256; j += 64) fv[j] = __expf(acv[(j & ~31) + 31] - acv[j]) * dtv[j];
    LDS_FENCE();
    __syncthreads();
    bf16_t* Zp = (bf16_t*)(ws + ZB);
    const float* hst = U.prm ? (const float*)(ws + STATES) + ((size_t)U.c * 32 + hd) * 8192 : p.in[6] + ((size_t)U.b * 32 + hd) * 8192;
    const float dsk = p.in[24][hd];
    const int ntile = (U.L + 31) >> 5;
    const bf16_t* xrow0 = XT + (((size_t)hd * NTB + (U.t0 >> 4)) * 64 + l32) * 16 + hi * 8;
    bf16x8 hf[8][2];
#pragma unroll
    for (int ks = 0; ks < 8; ++ks)
#pragma unroll
        for (int pt = 0; pt < 2; ++pt) { const float* hp = hst + (32 * pt + l32) * 128 + 16 * ks + hi * 8; const f32x4 h0 = *(const f32x4*)hp, h1 = *(const f32x4*)(hp + 4);
            u32x4 q; q.x = pk2(h0[0], h0[1]); q.y = pk2(h0[2], h0[3]); q.z = pk2(h1[0], h1[1]); q.w = pk2(h1[2], h1[3]); hf[ks][pt] = __builtin_bit_cast(bf16x8, q); }
    for (int it = 0; it < ntile; ++it) {
        const int i_loc = 32 * it + l32; const size_t ti = (size_t)U.t0 + i_loc;
        const bool valid = i_loc < U.L;
        bf16_t* zp = Zp + ti * 2048 + hd * 64 + 4 * hi;
        bf16x8 cf[8];
        { const int crow = 32 * it + l32; const unsigned char* cb_ = (const unsigned char*)Cl + crow * 256;
#pragma unroll
          for (int ks = 0; ks < 8; ++ks) cf[ks] = *(const bf16x8*)(cb_ + (((2 * ks + hi) ^ (crow & 15)) << 4)); }
        f32x16 acc[2]; acc[0] = zero16(); acc[1] = zero16();
#pragma unroll
        for (int ks = 0; ks < 8; ++ks)
#pragma unroll
            for (int pt = 0; pt < 2; ++pt) acc[pt] = mfma32(hf[ks][pt], cf[ks], acc[pt]);
        const float aci = acv[i_loc];
        { const float ei = __expf(aci); acc[0] *= ei; acc[1] *= ei; }
        for (int jt = 0; jt <= it; ++jt) {
            bf16x8 xc[2][2];
#pragma unroll
            for (int kk = 0; kk < 2; ++kk)
#pragma unroll
                for (int pt = 0; pt < 2; ++pt) xc[kk][pt] = *(const bf16x8*)(xrow0 + (size_t)(2 * jt + kk) * 1024 + pt * 512);
            f32x16 cb = zero16();
            { const int brow = 32 * jt + l32; const unsigned char* bb_ = (const unsigned char*)Bl + brow * 256;
#pragma unroll
              for (int ks = 0; ks < 8; ++ks) { const bf16x8 bfr = *(const bf16x8*)(bb_ + (((2 * ks + hi) ^ (brow & 15)) << 4)); cb = mfma32(bfr, cf[ks], cb); } }
            if (jt < it) {
                const float ei = __expf(aci - acv[32 * jt + 31]);
#pragma unroll
                for (int g4 = 0; g4 < 4; ++g4) { const f32x4 fj = *(const f32x4*)(fv + 32 * jt + 8 * g4 + 4 * hi);
#pragma unroll
                    for (int e = 0; e < 4; ++e) cb[4 * g4 + e] = cb[4 * g4 + e] * (fj[e] * ei); }
            } else {
#pragma unroll
                for (int g4 = 0; g4 < 4; ++g4) { const int jb = 32 * jt + 8 * g4 + 4 * hi; const f32x4 aj = *(const f32x4*)(acv + jb), dj = *(const f32x4*)(dtv + jb);
#pragma unroll
                    for (int e = 0; e < 4; ++e) { const int j = jb + e; const float d = fminf(aci - aj[e], 0.f);
                        float v = (j <= i_loc && j < U.L) ? cb[4 * g4 + e] * __expf(d) * dj[e] : 0.f; if (j == i_loc) v += dsk; cb[4 * g4 + e] = v; } }
            }
            bf16x8 mb[2]; mb[0] = pack8<0>(cb); mb[1] = pack8<8>(cb);
#pragma unroll
            for (int kk = 0; kk < 2; ++kk)
#pragma unroll
                for (int pt = 0; pt < 2; ++pt) acc[pt] = mfma32(xc[kk][pt], mb[kk], acc[pt]);
        }
        s16x4 zz[2][4];
#pragma unroll
        for (int pt = 0; pt < 2; ++pt)
#pragma unroll
            for (int g4 = 0; g4 < 4; ++g4) zz[pt][g4] = valid ? *(const s16x4*)(zp + 32 * pt + 8 * g4) : (s16x4){0, 0, 0, 0};
        float ss = 0.f;
#pragma unroll
        for (int pt = 0; pt < 2; ++pt)
#pragma unroll
            for (int g4 = 0; g4 < 4; ++g4)
#pragma unroll
                for (int e = 0; e < 4; ++e) { const float v = acc[pt][4 * g4 + e] * silu(bf2f(zz[pt][g4][e])); acc[pt][4 * g4 + e] = v; ss += v * v; }
        ss += __shfl_xor(ss, 32);
        float* rd = red + (it & 1) * 256;
        if (hi == 0) rd[w * 32 + l32] = ss;
        __syncthreads();
        float tot = 0.f;
#pragma unroll
        for (int ww = 0; ww < 8; ++ww) tot += rd[ww * 32 + l32];
        const float rstd = rsqrtf(tot * (1.f / 512.f) + EPS);
        if (valid) {
            const float* nw = p.in[25] + hd * 64 + 4 * hi;
#pragma unroll
            for (int pt = 0; pt < 2; ++pt)
#pragma unroll
                for (int g4 = 0; g4 < 4; ++g4) { const f32x4 gw4 = *(const f32x4*)(nw + 32 * pt + 8 * g4);
                    u32x2 o; o.x = pk2(acc[pt][4 * g4] * rstd * gw4[0], acc[pt][4 * g4 + 1] * rstd * gw4[1]); o.y = pk2(acc[pt][4 * g4 + 2] * rstd * gw4[2], acc[pt][4 * g4 + 3] * rstd * gw4[3]);
                    bf16_t* zo = dummy ? (bf16_t*)(ws + 23363584) + ((ti * 2048 + hd * 64 + 4 * hi) & 0x7FFFF) : zp;
                    *(u32x2*)(zo + 32 * pt + 8 * g4) = o; }
        }
    }
    __syncthreads();
}

#define XB_TMO      128
#define XB_XCNT(j)  (256  + 64 * (j))
#define XB_XSUB(j)  (1280 + 64 * (j))
#define XB_XGEN(j)  (2304 + 64 * (j))
#define XB_TOP      3328
#define XB_TOPGEN   3392
#define XCD_BAR_WORDS 3456
#define XB_SPIN_CAP (1u << 22)
DEV unsigned xb_ld(unsigned* p)              { return __hip_atomic_load(p, __ATOMIC_RELAXED, __HIP_MEMORY_SCOPE_AGENT); }
DEV unsigned xb_add(unsigned* p, unsigned v) { return __hip_atomic_fetch_add(p, v, __ATOMIC_RELAXED, __HIP_MEMORY_SCOPE_AGENT); }
DEV unsigned xb_xcc_id() { return (unsigned)__builtin_amdgcn_s_getreg((3 << 11) | 20) & 0xFu; }
#define XB_SPIN(cond, bar) do { unsigned _sp = 0; while (cond) { __builtin_amdgcn_s_sleep(1); \
    if ((++_sp & 255u) == 0u) { if (xb_ld(&(bar)[XB_TMO])) break; if (_sp > XB_SPIN_CAP) { atomicAdd(&(bar)[XB_TMO], 1u); break; } } } } while (0)
struct XcdBarrier { unsigned* bar; unsigned x; volatile LAS unsigned* st; };
DEV XcdBarrier xcd_barrier_post(unsigned* bar, volatile LAS unsigned* st) {
    XcdBarrier b; b.bar = bar; b.x = xb_xcc_id(); b.st = st;
    if (threadIdx.x == 0) (void)xb_add(&bar[XB_XCNT(b.x)], 1u);
    return b;
}
DEV void xcd_barrier_complete(unsigned* bar, unsigned x, unsigned& nloc, unsigned& nx) {
    const unsigned G = gridDim.x * gridDim.y * gridDim.z;
    unsigned sum, cnt, mine, sp = 0u;
    for (;;) {
        sum = 0u; cnt = 0u; mine = 0u;
#pragma unroll
        for (unsigned j = 0; j < 16; ++j) { const unsigned c = xb_ld(&bar[XB_XCNT(j)]); sum += c; cnt += (c > 0u) ? 1u : 0u; mine = (j == x) ? c : mine; }
        if (sum == G) break;
        __builtin_amdgcn_s_sleep(1);
        if ((++sp & 255u) == 0u) { if (xb_ld(&bar[XB_TMO])) break; if (sp > XB_SPIN_CAP) { atomicAdd(&bar[XB_TMO], 1u); break; } }
    }
    nloc = mine > 0u ? mine : 1u; nx = cnt > 0u ? cnt : 1u;
}
DEV void xcd_barrier(const XcdBarrier& b) {
    asm volatile("s_waitcnt vmcnt(0)" ::: "memory");
    __syncthreads();
    if (threadIdx.x == 0) {
        unsigned* bar = b.bar;
        __builtin_amdgcn_s_waitcnt(0);
        unsigned nloc = b.st[0], nx = b.st[1];
        if (nloc == 0u) { xcd_barrier_complete(bar, b.x, nloc, nx); b.st[0] = nloc; b.st[1] = nx; }
        const unsigned old = xb_add(&bar[XB_XSUB(b.x)], 1u);
        const unsigned gen = old / nloc;
        if (old + 1u == (gen + 1u) * nloc) {
            __builtin_amdgcn_fence(__ATOMIC_RELEASE, "agent");
            asm volatile("s_waitcnt vmcnt(0)" ::: "memory");
            const unsigned og = xb_add(&bar[XB_TOP], 1u);
            const unsigned tg = og / nx;
            if (og + 1u == (tg + 1u) * nx) xb_add(&bar[XB_TOPGEN], 1u);
            else XB_SPIN(xb_ld(&bar[XB_TOPGEN]) == tg, bar);
            __builtin_amdgcn_fence(__ATOMIC_ACQUIRE, "agent");
            xb_add(&bar[XB_XGEN(b.x)], 1u);
            asm volatile("s_waitcnt vmcnt(0)" ::: "memory");
        } else {
            XB_SPIN(xb_ld(&bar[XB_XGEN(b.x)]) == gen, bar);
            __builtin_amdgcn_fence(__ATOMIC_ACQUIRE, "agent");
            asm volatile("s_waitcnt vmcnt(0)" ::: "memory");
        }
    }
    __syncthreads();
}


template <bool OUT_F32>
DEV void sample_rows_fix(const float* base, float* Xs, const float* part, int nsl, const float* g, bf16_t* Hs, int gw, int NGW, int lane) {
    for (int r = NGW - 1 - gw; r < 256; r += NGW) {
        const float* pp = part + (size_t)r * 1024; float* xr = Xs + (size_t)r * 1024;
        f32x4 v[4]; float ss = 0.f;
#pragma unroll
        for (int j = 0; j < 4; ++j) v[j] = *(const f32x4*)(base + (size_t)r * 1024 + (64 * j + lane) * 4);
        for (int ks = 0; ks < nsl; ++ks) {
#pragma unroll
            for (int j = 0; j < 4; ++j) v[j] += *(const f32x4*)(pp + (size_t)ks * 262144 + (64 * j + lane) * 4); }
#pragma unroll
        for (int j = 0; j < 4; ++j) ss += (v[j][0] * v[j][0] + v[j][1] * v[j][1]) + (v[j][2] * v[j][2] + v[j][3] * v[j][3]);
        const float rstd = rsqrtf(wave_sum(ss) * (1.f / 1024.f) + EPS);
#pragma unroll
        for (int j = 0; j < 4; ++j) { const int o = (64 * j + lane) * 4; const f32x4 gg = *(const f32x4*)(g + o);
            if (OUT_F32) *(f32x4*)(xr + o) = v[j] * rstd * gg;
            else { *(f32x4*)(xr + o) = v[j];
                u32x2 q; q.x = pk2(v[j][0] * rstd * gg[0], v[j][1] * rstd * gg[1]); q.y = pk2(v[j][2] * rstd * gg[2], v[j][3] * rstd * gg[3]); *(u32x2*)(Hs + (size_t)r * 1024 + o) = q; } }
    }
}

#ifndef PHM
#define PHM 0x3fff
#endif
#ifndef SSDM
#define SSDM 7
#endif
typedef __attribute__((address_space(4))) const Params* KParams;
#define PLOAD() KParams kq_ = kp; asm volatile("" : "+s"(kq_)); Params p; __builtin_memcpy(&p, kq_, sizeof(Params)); unsigned char* ws = p.ws; unsigned char* ob = (unsigned char*)p.out; float* X = p.out; const int tid = otid(), lane = tid & 63, wave = tid >> 6, gw = bid * 8 + wave; (void)ws; (void)ob; (void)X; (void)lane; (void)gw;
__global__ void __launch_bounds__(512, 2) mega(Params p_arg) {
    extern __shared__ __attribute__((aligned(16))) unsigned char lds_raw[];
    cg::grid_group grid = cg::this_grid();
    LAS unsigned char* lds = (LAS unsigned char*)lds_raw;
    unsigned char* ldsg = lds_raw;
    const int G = gridDim.x, bid = blockIdx.x, NGW = G * 8;
    volatile LAS unsigned* xst = (volatile LAS unsigned*)(lds + 131072);
    if (threadIdx.x < 4) xst[threadIdx.x] = 0u;
    if (bid == 0) { unsigned* bw = (unsigned*)(p_arg.ws + XBAR); for (int i = threadIdx.x; i < XCD_BAR_WORDS; i += 512) bw[i] = 0u; }
    __syncthreads();
    XcdBarrier xbar; xbar.bar = (unsigned*)(p_arg.ws + XBAR); xbar.x = 0; xbar.st = xst;
#define GSYNC() xcd_barrier(xbar)
    const KParams kp = (KParams)__builtin_amdgcn_kernarg_segment_ptr();

#if PHM & 1
    { PLOAD();
    phase0(p, ldsg, gw, NGW, lane, wave);
    }
    grid.sync();
    xbar = xcd_barrier_post((unsigned*)(p_arg.ws + XBAR), xst);
#endif
#if PHM & 2
    { PLOAD();
    { pg8::Gemm g{(const bf16_t*)(ws + H0), (const bf16_t*)(ws + W_INAB), 1024, 1024, 1024}; pg8::StaticOrder S; S.init(T, 1280, G, bid);
      EpiBf16 E{(bf16_t*)(ws + PROJ), 1280, nullptr}; pg8::gemm_phase(lds, g, S, E);
    }
    { const int nb2 = 325 > G ? 325 - G : 0;
      if (bid >= nb2) { const int gw2 = (bid - nb2) * 8 + wave, NGW2 = (G - nb2) * 8; float* scr = (float*)(ldsg + wave * 8448); int rot = 0;
        convert_weight(p.in[18], 1024, 1024, (bf16_t*)(ws + W_OUTAB), 1024, 0, 0, 0, scr, gw2, NGW2, lane, rot);
        convert_weight(p.in[27], 1024, 2816, (bf16_t*)(ws + W_GU0), 1024, 0, 0, 1, scr, gw2, NGW2, lane, rot);
        convert_weight(p.in[28], 1024, 2816, (bf16_t*)(ws + W_GU0), 1024, 0, 0, 2, scr, gw2, NGW2, lane, rot);
        convert_weight(p.in[29], 2816, 1024, (bf16_t*)(ws + W_DN0), 2816, 0, 0, 0, scr, gw2, NGW2, lane, rot); } }
    }
    GSYNC();
#endif
#if PHM & 4
    { PLOAD();
    phase2(p, gw, NGW, lane);
    }
    GSYNC();
#endif
#if PHM & 8
    { PLOAD();
    { pg8::Gemm g{(const bf16_t*)(ws + POOLED), (const bf16_t*)(ws + W_POOL), 512, 512, 512}; pg8::StaticOrder S; S.init(T, 512, G, bid);
      EpiBf16 E{(bf16_t*)(ws + CAT), 1024, p.in[12]}; pg8::gemm_phase(lds, g, S, E); }
    { pg8::Gemm g{(const bf16_t*)(ws + QLN), (const bf16_t*)(ws + W_UQ), 384, 384, 384}; pg8::StaticOrder S; S.init(T, 768, G, (bid + 80) % G);
      EpiBf16 E{(bf16_t*)(ob + D_QRAW), 768, nullptr}; pg8::gemm_phase(lds, g, S, E); }
    { pg8::Gemm g{(const bf16_t*)(ob + D_CKVALL), (const bf16_t*)(ws + W_UK), 256, 256, 256}; pg8::StaticOrder S; S.init(NK, 512, G, (bid + 136) % G);
      EpiBf16 E{(bf16_t*)(ws + KNOPE), 512, nullptr}; pg8::gemm_phase(lds, g, S, E); }
    { pg8::Gemm g{(const bf16_t*)(ws + W_UV), (const bf16_t*)(ob + D_CKVALL), 256, 256, 256}; pg8::StaticOrder S; S.init(512, NK, G, (bid + 136) % G);
      EpiBf16 E{(bf16_t*)(ws + VT), (size_t)NK, nullptr}; pg8::gemm_phase(lds, g, S, E); }
    }
    GSYNC();
#endif
#if PHM & 16
    { PLOAD();
    { AttnPtrs A{(const bf16_t*)(ob + D_QRAW), (const bf16_t*)(ws + KNOPE), (const bf16_t*)(ob + D_KPEALL), (const bf16_t*)(ws + VT), (const float*)(ob + D_ROPE), (bf16_t*)(ws + CAT)};
      for (int pi = bid; pi < 256; pi += G) { const int h = pi & 7, x = pi >> 3, xx = x & 15, base = 4 * (xx >> 1) + (xx & 1);
          const int qlo = x < 16 ? base : base + 2, qhi = x < 16 ? 61 - base : 63 - base;
          attn_prompt_unit(A, ldsg, h, qhi); attn_prompt_unit(A, ldsg, h, qlo); }
      for (int su = bid; su < 128; su += G) attn_sample_unit(A, ldsg, su >> 3, su & 7); }
    }
    GSYNC();
#endif
#if PHM & 32
    { PLOAD();
    { pg8::Gemm g{(const bf16_t*)(ws + CAT), (const bf16_t*)(ws + W_OUTAB), 1024, 1024, 1024}; pg8::ChainOrder S; S.a.init(TPR, 1024, G, bid); S.b = pg8::SplitOrder{64, 4, 4, 256, G, bid}; S.init();
      EpiResChain E{EpiRes{X, p.in[0], p.in[1], 0}, EpiRes{(float*)(ws + PART), nullptr, nullptr, 3}}; pg8::gemm_phase(lds, g, S, E);
    }
    }
    GSYNC();
#endif
#if PHM & 64
    { PLOAD();
    rms_phase(X, p.in[8], (bf16_t*)(ws + HF), gw, NGW, lane, TPR);
    sample_rows_fix<false>(p.in[1], X + (size_t)TPR * 1024, (const float*)(ws + PART), 4, p.in[8], (bf16_t*)(ws + HF) + (size_t)TPR * 1024, gw, NGW, lane);
    GSYNC();
    { pg8::Gemm g{(const bf16_t*)(ws + HF), (const bf16_t*)(ws + W_GU0), 1024, 1024, 1024}; pg8::StaticOrder S; S.init(T, 5632, G, bid);
      EpiSwiglu E{(bf16_t*)(ws + GF0)}; pg8::gemm_phase(lds, g, S, E);
    }
    GSYNC();
    { pg8::Gemm g{(const bf16_t*)(ws + GF0), (const bf16_t*)(ws + W_DN0), 2816, 2816, 2816}; pg8::ChainOrder S; S.a.init(TPR, 1024, G, bid); S.b = pg8::SplitOrder{64, 4, 11, 256, G, bid}; S.init();
      EpiResChain E{EpiRes{X, nullptr, nullptr, 1}, EpiRes{(float*)(ws + PART8), nullptr, nullptr, 3}}; pg8::gemm_phase(lds, g, S, E); }
    { const int nb2 = 44 < G ? 44 : 0;
      if (bid >= nb2) { const int gw2 = (bid - nb2) * 8 + wave, NGW2 = (G - nb2) * 8; float* scr = (float*)(ldsg + wave * 8448); int rot = 0;
        convert_weight(p.in[19], 1024, 5152, (bf16_t*)(ws + W_INC), 1024, 0, 0, 0, scr, gw2, NGW2, lane, rot);
        const int gt = gw2 * 64 + lane, NGT = NGW2 * 64; const u32x4 z4 = {0u, 0u, 0u, 0u};
        for (int i = gt; i < 224 * 128; i += NGT) *(u32x4*)(ws + W_INC + (size_t)5152 * 2048 + (size_t)i * 16) = z4; } }
    }
    GSYNC();
#endif
#if PHM & 128
    { PLOAD();
    rms_phase(X, p.in[7] + 1024, (bf16_t*)(ws + H1), gw, NGW, lane, TPR);
    sample_rows_fix<false>(X + (size_t)TPR * 1024, X + (size_t)TPR * 1024, (const float*)(ws + PART8), 11, p.in[7] + 1024, (bf16_t*)(ws + H1) + (size_t)TPR * 1024, gw, NGW, lane);
    { float* scr = (float*)(ldsg + wave * 8448); int rot = 0;
      convert_weight(p.in[26], 2048, 1024, (bf16_t*)(ws + W_OUTC), 2048, 0, 0, 0, scr, gw, NGW, lane, rot); }
    }
    GSYNC();
#endif
#if PHM & 256
    { PLOAD();
    { pg8::Gemm g{(const bf16_t*)(ws + H1), (const bf16_t*)(ws + W_INC), 1024, 1024, 1024}; pg8::StaticOrder S; S.init(T, 5376, G, bid);
      EpiInC E{(bf16_t*)(ws + ZB), (bf16_t*)(ws + XRAW), (bf16_t*)(ws + BCRAW), (float*)(ws + DTB), p.in[22]}; pg8::gemm_phase(lds, g, S, E);
    }
    }
    GSYNC();
#endif
#if PHM & 512
    { PLOAD();
    conv_phase<false>(p, ldsg, bid, G);
    }
    GSYNC();
#endif
#if PHM & 1024
    { PLOAD();
#if SSDM & 1
    for (int u = bid; u < 320; u += G) {
        conv_phase<true>(p, ldsg, bid, G, u);
        asm volatile("s_waitcnt vmcnt(0)" ::: "memory"); __syncthreads();
        ssd_s1_unit(p, ldsg, u);
        __syncthreads();
    }
#endif
    GSYNC();
#if SSDM & 2
    ssd_s2(p, G);
#endif
    GSYNC();
#if SSDM & 4
    for (int u = bid; u < 320; u += G) ssd_s3_unit<false>(p, ldsg, u);
#endif
    }
    GSYNC();
#endif
#if PHM & 2048
    { PLOAD();
    { pg8::Gemm g{(const bf16_t*)(ws + ZB), (const bf16_t*)(ws + W_OUTC), 2048, 2048, 2048}; pg8::ChainOrder S; S.a.init(TPR, 1024, G, bid); S.b = pg8::SplitOrder{64, 4, 8, 256, G, bid}; S.init();
      EpiResChain E{EpiRes{X, nullptr, nullptr, 1}, EpiRes{(float*)(ws + PART13), nullptr, nullptr, 3}}; pg8::gemm_phase(lds, g, S, E);
      const int nb2 = 32 < G ? 32 : 0;
      if (bid >= nb2) { const int gw2 = (bid - nb2) * 8 + wave, NGW2 = (G - nb2) * 8; float* scr = (float*)(ldsg + wave * 8448); int rot = 0;
        convert_weight(p.in[27] + (size_t)1024 * 2816, 1024, 2816, (bf16_t*)(ws + W_GU1), 1024, 0, 0, 1, scr, gw2, NGW2, lane, rot);
        convert_weight(p.in[28] + (size_t)1024 * 2816, 1024, 2816, (bf16_t*)(ws + W_GU1), 1024, 0, 0, 2, scr, gw2, NGW2, lane, rot);
        convert_weight(p.in[29] + (size_t)2816 * 1024, 2816, 1024, (bf16_t*)(ws + W_DN1), 2816, 0, 0, 0, scr, gw2, NGW2, lane, rot); } }
    }
    GSYNC();
#endif
#if PHM & 4096
    { PLOAD();
    rms_phase(X, p.in[8] + 1024, (bf16_t*)(ws + H2), gw, NGW, lane, TPR);
    sample_rows_fix<false>(X + (size_t)TPR * 1024, X + (size_t)TPR * 1024, (const float*)(ws + PART13), 8, p.in[8] + 1024, (bf16_t*)(ws + H2) + (size_t)TPR * 1024, gw, NGW, lane);
    GSYNC();
    { pg8::Gemm g{(const bf16_t*)(ws + H2), (const bf16_t*)(ws + W_GU1), 1024, 1024, 1024}; pg8::StaticOrder S; S.init(T, 5632, G, bid);
      EpiSwiglu E{(bf16_t*)(ws + GF1)}; pg8::gemm_phase(lds, g, S, E); }
    GSYNC();
    { pg8::Gemm g{(const bf16_t*)(ws + GF1), (const bf16_t*)(ws + W_DN1), 2816, 2816, 2816}; pg8::ChainOrder S; S.a.init(TPR, 1024, G, bid); S.b = pg8::SplitOrder{64, 4, 11, 256, G, bid}; S.init();
      EpiResChain E{EpiRes{X, nullptr, nullptr, 1}, EpiRes{(float*)(ws + PART16), nullptr, nullptr, 3}}; pg8::gemm_phase(lds, g, S, E); }
    }
    GSYNC();
#endif
#if PHM & 8192
    { PLOAD();
    { f32x4 gg[4];
#pragma unroll
      for (int j = 0; j < 4; ++j) gg[j] = *(const f32x4*)(p.in[9] + (64 * j + lane) * 4);
      for (int t = gw; t < TPR; t += 2 * NGW) {
        const int t2 = t + NGW; const bool two = t2 < TPR; const int tb_ = two ? t2 : t;
        float* xa = X + (size_t)t * 1024; float* xb = X + (size_t)tb_ * 1024;
        f32x4 v[4], u[4]; float sa = 0.f, sb = 0.f;
#pragma unroll
        for (int j = 0; j < 4; ++j) { v[j] = *(const f32x4*)(xa + (64 * j + lane) * 4); u[j] = *(const f32x4*)(xb + (64 * j + lane) * 4); }
#pragma unroll
        for (int j = 0; j < 4; ++j) { sa += (v[j][0] * v[j][0] + v[j][1] * v[j][1]) + (v[j][2] * v[j][2] + v[j][3] * v[j][3]); sb += (u[j][0] * u[j][0] + u[j][1] * u[j][1]) + (u[j][2] * u[j][2] + u[j][3] * u[j][3]); }
#pragma unroll
        for (int o = 1; o < 64; o <<= 1) { sa += __shfl_xor(sa, o); sb += __shfl_xor(sb, o); }
        const float ra = rsqrtf(sa * (1.f / 1024.f) + EPS), rb = rsqrtf(sb * (1.f / 1024.f) + EPS);
#pragma unroll
        for (int j = 0; j < 4; ++j) *(f32x4*)(xa + (64 * j + lane) * 4) = v[j] * ra * gg[j];
        if (two) {
#pragma unroll
            for (int j = 0; j < 4; ++j) *(f32x4*)(xb + (64 * j + lane) * 4) = u[j] * rb * gg[j]; }
      } }
    sample_rows_fix<true>(X + (size_t)TPR * 1024, X + (size_t)TPR * 1024, (const float*)(ws + PART16), 11, p.in[9], nullptr, gw, NGW, lane);
    }
#endif
}

extern "C" void kernel_launch(void* const* d_in, const int* in_sizes, int n_in, void* d_out, int out_size, void* d_ws, size_t ws_size, hipStream_t stream) {
    constexpr int kLds = 131072 + 64 + 16384 + 2048 + 8192;
    static int grid = 0;
    if (grid == 0) {
        if (n_in != 30 || ws_size < WS_NEED) { fprintf(stderr, "kernel_launch: unexpected n_in %d or workspace %zu < %zu\n", n_in, ws_size, (size_t)WS_NEED); grid = -1; return; }
        int dev = 0, cus = 0, per_cu = 0;
        hipGetDevice(&dev); hipDeviceGetAttribute(&cus, hipDeviceAttributeMultiprocessorCount, dev);
        if (hipFuncSetAttribute((const void*)mega, hipFuncAttributeMaxDynamicSharedMemorySize, kLds) != hipSuccess) { fprintf(stderr, "kernel_launch: hipFuncSetAttribute failed\n"); grid = -1; return; }
        if (hipOccupancyMaxActiveBlocksPerMultiprocessor(&per_cu, (const void*)mega, 512, kLds) != hipSuccess || per_cu < 1) { fprintf(stderr, "kernel_launch: occupancy query says %d\n", per_cu); grid = -1; (void)hipGetLastError(); return; }
        grid = cus;
    }
    if (grid < 0) return;
    Params prm{};
    for (int i = 0; i < 30; ++i) prm.in[i] = (const float*)d_in[i];
    prm.out = (float*)d_out; prm.ws = (unsigned char*)d_ws;
    void* args[] = {&prm};
    hipError_t e = hipLaunchCooperativeKernel((const void*)mega, dim3(grid), dim3(512), args, kLds, stream);
    if (e != hipSuccess) fprintf(stderr, "kernel_launch: cooperative launch failed: %s (grid %d)\n", hipGetErrorString(e), grid);
}
```

```cpp
#include <hip/hip_runtime.h>
#include <hip/hip_cooperative_groups.h>
#include <cstdio>
namespace cg = cooperative_groups;

#define DEV __device__ __forceinline__
#define LAS __attribute__((address_space(3)))
typedef unsigned short bf16_t;
typedef short bf16x8 __attribute__((ext_vector_type(8)));
typedef short s16x4 __attribute__((ext_vector_type(4)));
typedef float f32x4 __attribute__((ext_vector_type(4)));
typedef float f32x2 __attribute__((ext_vector_type(2)));
typedef float f32x16 __attribute__((ext_vector_type(16)));
typedef unsigned u32x4 __attribute__((ext_vector_type(4)));
typedef unsigned u32x2 __attribute__((ext_vector_type(2)));
typedef __bf16 bf16v2 __attribute__((ext_vector_type(2)));

constexpr int T = 16640;
constexpr int TPR = 16384;
constexpr int TP = 16704;
constexpr int NTB = TP / 16;
constexpr int NK = 82176;
constexpr int SKV = 4112;
constexpr float EPS = 1e-6f;
constexpr float QSCALE = 0.10206207261596577f * 1.4426950408889634f;

constexpr size_t W_INAB = 0, W_POOL = 2621440, W_UQ = 3145728, W_UK = 3735552, W_UV = 3997696, W_OUTAB = 4259840, W_GU0 = 6356992, W_DN0 = 17891328;
constexpr size_t R1 = 25165824;
constexpr size_t KNOPE = R1, VT = KNOPE + 84148224, CAT = VT + 84148224, POOLED = CAT + 34078720, QLN = POOLED + 17039360;
constexpr size_t H0 = KNOPE, PROJ = VT;
constexpr size_t HF = R1, GF0 = R1 + 34078720;
constexpr size_t DTB = 0, CN = 2129920, W_OUTC = 19169280, W_GU1 = 0, W_DN1 = 11534336;
constexpr size_t ZB = 25165824, XRAW = 93323264, STATES = XRAW, RT = 161480704, BCRAW = RT, XTB = RT, H1 = RT + 34078720;
constexpr size_t RB = 229900288, BN = RB, BTB = RB + 17039360, W_INC = RB, DEC = 264044544;
constexpr size_t H2 = RT, GF1 = ZB;
constexpr size_t XBAR = DEC + 8192;
constexpr size_t PART = XBAR + 16384;
constexpr size_t PART8 = 240910336, PART13 = XRAW, PART16 = RT;
constexpr size_t WS_NEED = PART + 4194304;
constexpr size_t O_YS = 16777216, O_CKVP = 17039360, O_KPEP = 21233664, O_POOLP = 21757952, O_CONVP = 21765632, O_SSMP = 21774848,
                 O_CKVS = 22036992, O_KPES = 22102528, O_POOLS = 22110720, O_CONVS = 22233600, O_SSMS = 22381056;
constexpr size_t D_CKVALL = 0, D_QRAW = 42074112, D_KPEALL = O_SSMS * 4, D_ROPE = O_SSMS * 4 + 5259264;

struct Params { const float* in[30]; float* out; unsigned char* ws; };

DEV unsigned pk2(float a, float b) { f32x2 v = {a, b}; bf16v2 r = __builtin_convertvector(v, bf16v2); return __builtin_bit_cast(unsigned, r); }
DEV float bf2f(short v) { return __uint_as_float(((unsigned)(unsigned short)v) << 16); }
DEV float wave_sum(float v) {
#pragma unroll
    for (int o = 1; o < 64; o <<= 1) v += __shfl_xor(v, o);
    return v;
}
DEV float silu(float x) { return x * __builtin_amdgcn_rcpf(1.0f + __expf(-x)); }
DEV f32x16 mfma32(bf16x8 a, bf16x8 b, f32x16 c) { return __builtin_amdgcn_mfma_f32_32x32x16_bf16(a, b, c, 0, 0, 0); }
DEV f32x16 zero16() { f32x16 z;
#pragma unroll
    for (int i = 0; i < 16; ++i) z[i] = 0.f; return z; }
template <int BASE> DEV bf16x8 pack8(const f32x16& x) {
    u32x4 p; p.x = pk2(x[BASE], x[BASE + 1]); p.y = pk2(x[BASE + 2], x[BASE + 3]); p.z = pk2(x[BASE + 4], x[BASE + 5]); p.w = pk2(x[BASE + 6], x[BASE + 7]);
    return __builtin_bit_cast(bf16x8, p);
}
DEV bf16x8 cat4(s16x4 lo, s16x4 hi) { return __builtin_shufflevector(lo, hi, 0, 1, 2, 3, 4, 5, 6, 7); }
#define LDS_FENCE() asm volatile("s_waitcnt lgkmcnt(0)" ::: "memory")
DEV int otid() { int t = threadIdx.x; asm volatile("" : "+v"(t)); return t; }

namespace pg8 {
constexpr int BM = 256, BK = 64, HALF = 128, HTB = HALF * BK * 2, STAGE_BYTES = 8 * HTB, NXCD = 8, WGM = 8;
DEV int lds_byte(int r, int c) { const int st = (r >> 4) * 2 + (c >> 5), rr = r & 15, cc = c & 31, ob = rr * 64 + cc * 2; return st * 1024 + (ob ^ (((ob >> 9) & 1) << 5)); }
DEV void stage_rc(int b, int& R, int& C) { const int st = b / 1024, sb = b % 1024, swz = sb ^ (((sb >> 9) & 1) << 5); R = (st >> 1) * 16 + swz / 64; C = (st & 1) * 32 + (swz % 64) / 2; }
DEV int perm32(int rho) { const int n = rho >> 4, i = rho & 15; return 8 * (i >> 2) + 4 * n + (i & 3); }
struct Unit { int pm, pn, k0, nt, flag; };
struct Gemm { const bf16_t* A; const bf16_t* Bt; int lda, ldb, K; };
struct StaticOrder {
    int nM, nN, nwg, G, c;
    DEV void init(int M, int N, int G_, int c_) { nM = M / BM; nN = N / BM; nwg = nM * nN; G = G_; c = c_; }
    DEV bool next(int i, Unit& u) const {
        const long L = (long)i * G + c; if (L >= nwg) return false;
        int wgid = (int)L; { const int q = nwg / NXCD, r = nwg % NXCD, xcd = wgid % NXCD, off = wgid / NXCD; wgid = (xcd < r ? xcd * (q + 1) : r * (q + 1) + (xcd - r) * q) + off; }
        const int nig = WGM * nN, gid = wgid / nig, fm = gid * WGM, gsz = (nM - fm) < WGM ? (nM - fm) : WGM;
        u.pm = fm + ((wgid % nig) % gsz); u.pn = (wgid % nig) / gsz; u.k0 = 0; u.nt = 0; u.flag = 0; return true;
    }
};
struct SplitOrder {
    int pm0, nN, nsplit, ksplit, G, c;
    DEV bool next(int i, Unit& u) const {
        const long L = (long)i * G + c; if (L >= (long)nN * nsplit) return false;
        u.pm = pm0; u.pn = (int)(L % nN); u.k0 = (int)(L / nN) * ksplit; u.nt = ksplit / BK; u.flag = 1; return true;
    }
};
struct ChainOrder {
    StaticOrder a; SplitOrder b; int na;
    DEV void init() { na = a.c < a.nwg ? (a.nwg - 1 - a.c) / a.G + 1 : 0; }
    DEV bool next(int i, Unit& u) const { return i < na ? a.next(i, u) : b.next(i - na, u); }
};

template <class Epi, class Sched>
DEV void gemm_phase(LAS unsigned char* lds, const Gemm g, const Sched& S, const Epi& E) {
    const int tid = otid(), wid = __builtin_amdgcn_readfirstlane(tid >> 6), lane = tid & 63, wr = wid >> 2, wc = wid & 3, fr = lane & 15, fq = lane >> 4;
    const int nt_def = g.K / BK;
    unsigned voffA[2], voffB[2];
#pragma unroll
    for (int i = 0; i < 2; ++i) { int R, C; stage_rc(tid * 16 + i * 8192, R, C); const int Rb = Epi::PERM ? ((R & ~31) + perm32(R & 31)) : R;
        voffA[i] = (unsigned)(R * g.lda + C) * 2u; voffB[i] = (unsigned)(Rb * g.ldb + C) * 2u; }
    const size_t kstep = (size_t)(BK * 2);
    const size_t hstepA = (size_t)HALF * g.lda * 2, hstepB = (size_t)HALF * g.ldb * 2;
    const size_t tstepA = 2 * hstepA, tstepB = 2 * hstepB;
    const unsigned ldsw = (unsigned)wid * 1024u;
    const int aoff = lds_byte(wr * 64 + fr, fq * 8), boff = lds_byte(wc * 32 + fr, fq * 8);
#define PG8_SA(b, h) (((b) * 2 + (h)) * HTB)
#define PG8_SB(b, h) ((4 + (b) * 2 + (h)) * HTB)
#define PG8_STAGE(bufoff, gbase, voff) do { _Pragma("unroll") for (int _i = 0; _i < 2; ++_i) \
        __builtin_amdgcn_global_load_lds((const unsigned*)((const char*)(gbase) + (voff)[_i]), (LAS unsigned*)(lds + (bufoff) + ldsw + _i * 8192), 16, 0, 0); } while (0)
#define PG8_LDA(dst, b, h) do { _Pragma("unroll") for (int m = 0; m < 4; ++m) _Pragma("unroll") for (int k = 0; k < 2; ++k) dst[m][k] = *(const LAS bf16x8*)(lds + PG8_SA(b, h) + aoff + m * 2048 + k * 1024); } while (0)
#define PG8_LDB(dst, b, h) do { _Pragma("unroll") for (int n = 0; n < 2; ++n) _Pragma("unroll") for (int k = 0; k < 2; ++k) dst[n][k] = *(const LAS bf16x8*)(lds + PG8_SB(b, h) + boff + n * 2048 + k * 1024); } while (0)
#define PG8_MMA(ai, bj, At, Bt) do { __builtin_amdgcn_s_setprio(1); _Pragma("unroll") for (int m = 0; m < 4; ++m) _Pragma("unroll") for (int n = 0; n < 2; ++n) _Pragma("unroll") for (int k = 0; k < 2; ++k) \
        acc[ai][bj][m][n] = __builtin_amdgcn_mfma_f32_16x16x32_bf16(Bt[n][k], At[m][k], acc[ai][bj][m][n], 0, 0, 0); __builtin_amdgcn_s_setprio(0); } while (0)
#define PG8_WAIT_V(n) asm volatile("s_waitcnt vmcnt(" #n ")" ::: "memory")
#define PG8_WAIT_L(n) asm volatile("s_waitcnt lgkmcnt(" #n ")" ::: "memory")
#define PG8_BAR __builtin_amdgcn_s_barrier()
#define PG8_SCHED __builtin_amdgcn_sched_barrier(0)
    Unit cur, nxt; int ui = 0;
    if (!S.next(0, cur)) return;
    f32x4 acc[2][2][4][2];
#pragma unroll
    for (int a = 0; a < 2; ++a)
#pragma unroll
        for (int b = 0; b < 2; ++b)
#pragma unroll
            for (int m = 0; m < 4; ++m)
#pragma unroll
                for (int n = 0; n < 2; ++n) acc[a][b][m][n] = (f32x4){0.f, 0.f, 0.f, 0.f};
    bf16x8 At[4][2], B0[2][2], B1[2][2];
    const char* cA = (const char*)g.A + (size_t)cur.pm * tstepA + (size_t)cur.k0 * 2; const char* cB = (const char*)g.Bt + (size_t)cur.pn * tstepB + (size_t)cur.k0 * 2;
    PG8_STAGE(PG8_SB(0, 0), cB, voffB); PG8_STAGE(PG8_SA(0, 0), cA, voffA); PG8_STAGE(PG8_SB(0, 1), cB + hstepB, voffB); PG8_STAGE(PG8_SA(0, 1), cA + hstepA, voffA);
    if (wr == 1) PG8_BAR;
    PG8_WAIT_V(4); PG8_BAR;
    PG8_STAGE(PG8_SB(1, 0), cB + kstep, voffB); PG8_STAGE(PG8_SA(1, 0), cA + kstep, voffA); PG8_STAGE(PG8_SB(1, 1), cB + hstepB + kstep, voffB);
    PG8_WAIT_V(6); PG8_BAR;
    for (;;) {
        const bool has_next = S.next(ui + 1, nxt);
        const int nt = cur.nt ? cur.nt : nt_def;
        const char* nA = has_next ? (const char*)g.A + (size_t)nxt.pm * tstepA + (size_t)nxt.k0 * 2 : cA; const char* nB = has_next ? (const char*)g.Bt + (size_t)nxt.pn * tstepB + (size_t)nxt.k0 * 2 : cB;
        for (int t = 0; t < nt; t += 2) {
            const bool last = (t == nt - 2);
            const char* a1 = cA + (size_t)(t + 1) * kstep;
            const char* a2 = last ? nA : cA + (size_t)(t + 2) * kstep; const char* b2 = last ? nB : cB + (size_t)(t + 2) * kstep;
            const char* a3 = a2 + kstep; const char* b3 = b2 + kstep;
            PG8_LDB(B0, 0, 0); PG8_SCHED; PG8_LDA(At, 0, 0); PG8_STAGE(PG8_SA(1, 1), a1 + hstepA, voffA);
            PG8_WAIT_L(8); PG8_BAR; PG8_WAIT_L(0); PG8_MMA(0, 0, At, B0); PG8_BAR; PG8_SCHED;
            PG8_LDB(B1, 0, 1); PG8_STAGE(PG8_SB(0, 0), b2, voffB);
            PG8_BAR; PG8_WAIT_L(0); PG8_MMA(0, 1, At, B1); PG8_BAR;
            PG8_LDA(At, 0, 1); PG8_STAGE(PG8_SA(0, 0), a2, voffA);
            PG8_BAR; PG8_WAIT_L(0); PG8_MMA(1, 0, At, B0); PG8_BAR; PG8_SCHED;
            PG8_STAGE(PG8_SB(0, 1), b2 + hstepB, voffB);
            PG8_WAIT_V(6); PG8_BAR; PG8_MMA(1, 1, At, B1); PG8_BAR;
            PG8_LDB(B0, 1, 0); PG8_SCHED; PG8_LDA(At, 1, 0); PG8_STAGE(PG8_SA(0, 1), a2 + hstepA, voffA);
            PG8_WAIT_L(8); PG8_BAR; PG8_WAIT_L(0); PG8_MMA(0, 0, At, B0); PG8_BAR; PG8_SCHED;
            PG8_LDB(B1, 1, 1); PG8_STAGE(PG8_SB(1, 0), b3, voffB);
            PG8_BAR; PG8_WAIT_L(0); PG8_MMA(0, 1, At, B1); PG8_BAR;
            PG8_LDA(At, 1, 1); PG8_STAGE(PG8_SA(1, 0), a3, voffA);
            PG8_BAR; PG8_WAIT_L(0); PG8_MMA(1, 0, At, B0); PG8_BAR; PG8_SCHED;
            PG8_STAGE(PG8_SB(1, 1), b3 + hstepB, voffB);
            PG8_WAIT_V(6); PG8_BAR; PG8_MMA(1, 1, At, B1); PG8_BAR;
        }
        E(acc, cur, wr, wc, fr, fq);
        if (!has_next) break;
#pragma unroll
        for (int a = 0; a < 2; ++a)
#pragma unroll
            for (int b = 0; b < 2; ++b)
#pragma unroll
                for (int m = 0; m < 4; ++m)
#pragma unroll
                    for (int n = 0; n < 2; ++n) acc[a][b][m][n] = (f32x4){0.f, 0.f, 0.f, 0.f};
        cur = nxt; cA = nA; cB = nB; ++ui;
    }
    PG8_WAIT_V(0);
    if (wr == 0) PG8_BAR;
    PG8_BAR;
#undef PG8_SA
#undef PG8_SB
#undef PG8_STAGE
#undef PG8_LDA
#undef PG8_LDB
#undef PG8_MMA
#undef PG8_WAIT_V
#undef PG8_WAIT_L
#undef PG8_BAR
#undef PG8_SCHED
}
}

struct EpiBf16 {
    static constexpr bool PERM = true;
    bf16_t* O; size_t ldc; const float* cscale;
    DEV void operator()(const f32x4 (&acc)[2][2][4][2], const pg8::Unit& u, int wr, int wc, int fr, int fq) const {
        const int row0 = u.pm * 256 + wr * 64 + fr, col0 = u.pn * 256 + wc * 32 + 8 * fq;
        f32x4 sc[2][2];
#pragma unroll
        for (int bj = 0; bj < 2; ++bj)
#pragma unroll
            for (int n = 0; n < 2; ++n) sc[bj][n] = cscale ? *(const f32x4*)(cscale + col0 + bj * 128 + 4 * n) : (f32x4){1.f, 1.f, 1.f, 1.f};
#pragma unroll
        for (int ai = 0; ai < 2; ++ai)
#pragma unroll
            for (int m = 0; m < 4; ++m) { bf16_t* rowp = O + (size_t)(row0 + ai * 128 + m * 16) * ldc + col0;
#pragma unroll
                for (int bj = 0; bj < 2; ++bj) { const f32x4 v0 = acc[ai][bj][m][0] * sc[bj][0], v1 = acc[ai][bj][m][1] * sc[bj][1];
                    u32x4 w; w.x = pk2(v0[0], v0[1]); w.y = pk2(v0[2], v0[3]); w.z = pk2(v1[0], v1[1]); w.w = pk2(v1[2], v1[3]);
                    *(u32x4*)(rowp + bj * 128) = w; } }
    }
};
struct EpiSwiglu {
    static constexpr bool PERM = true;
    bf16_t* G;
    DEV void operator()(const f32x4 (&acc)[2][2][4][2], const pg8::Unit& u, int wr, int wc, int fr, int fq) const {
        const int row0 = u.pm * 256 + wr * 64 + fr, col0 = u.pn * 128 + wc * 16 + 4 * fq;
#pragma unroll
        for (int ai = 0; ai < 2; ++ai)
#pragma unroll
            for (int m = 0; m < 4; ++m) { bf16_t* rowp = G + (size_t)(row0 + ai * 128 + m * 16) * 2816 + col0;
#pragma unroll
                for (int bj = 0; bj < 2; ++bj) { const f32x4 g = acc[ai][bj][m][0], up = acc[ai][bj][m][1];
                    u32x2 w; w.x = pk2(silu(g[0]) * up[0], silu(g[1]) * up[1]); w.y = pk2(silu(g[2]) * up[2], silu(g[3]) * up[3]);
                    *(u32x2*)(rowp + bj * 64) = w; } }
    }
};
struct EpiRes {
    static constexpr bool PERM = false;
    float* X; const float* xp; const float* xs; int mode;
    DEV void operator()(const f32x4 (&acc)[2][2][4][2], const pg8::Unit& u, int wr, int wc, int fr, int fq) const {
        const int row0 = u.pm * 256 + wr * 64 + fr, col0 = u.pn * 256 + wc * 32 + 4 * fq;
        if (mode == 2) {
#pragma unroll
            for (int ai = 0; ai < 2; ++ai)
#pragma unroll
                for (int m = 0; m < 4; ++m) { float* op = X + (size_t)(row0 + ai * 128 + m * 16) * 1024 + col0;
#pragma unroll
                    for (int bj = 0; bj < 2; ++bj)
#pragma unroll
                        for (int n = 0; n < 2; ++n) { const f32x4 a = acc[ai][bj][m][n]; const int o = bj * 128 + n * 16;
                            unsafeAtomicAdd(op + o, a[0]); unsafeAtomicAdd(op + o + 1, a[1]); unsafeAtomicAdd(op + o + 2, a[2]); unsafeAtomicAdd(op + o + 3, a[3]); } }
            return;
        }
        if (mode == 3) {
#pragma unroll
            for (int ai = 0; ai < 2; ++ai)
#pragma unroll
                for (int m = 0; m < 4; ++m) { float* op = X + ((size_t)(u.k0 >> 8) * 256 + (row0 + ai * 128 + m * 16 - TPR)) * 1024 + col0;
#pragma unroll
                    for (int bj = 0; bj < 2; ++bj)
#pragma unroll
                        for (int n = 0; n < 2; ++n) *(f32x4*)(op + bj * 128 + n * 16) = acc[ai][bj][m][n]; }
            return;
        }
#pragma unroll
        for (int ai = 0; ai < 2; ++ai) {
            f32x4 bs[4][2][2];
#pragma unroll
            for (int m = 0; m < 4; ++m) { const int row = row0 + ai * 128 + m * 16;
                const float* bp = (mode == 0) ? (row < TPR ? xp + (size_t)row * 1024 : xs + (size_t)(row - TPR) * 1024) + col0 : X + (size_t)row * 1024 + col0;
#pragma unroll
                for (int bj = 0; bj < 2; ++bj)
#pragma unroll
                    for (int n = 0; n < 2; ++n) bs[m][bj][n] = *(const f32x4*)(bp + bj * 128 + n * 16); }
#pragma unroll
            for (int m = 0; m < 4; ++m) { float* op = X + (size_t)(row0 + ai * 128 + m * 16) * 1024 + col0;
#pragma unroll
                for (int bj = 0; bj < 2; ++bj)
#pragma unroll
                    for (int n = 0; n < 2; ++n) *(f32x4*)(op + bj * 128 + n * 16) = acc[ai][bj][m][n] + bs[m][bj][n]; }
        }
    }
};
struct EpiResChain {
    static constexpr bool PERM = false;
    EpiRes m, s;
    DEV void operator()(const f32x4 (&acc)[2][2][4][2], const pg8::Unit& u, int wr, int wc, int fr, int fq) const { if (u.flag) s(acc, u, wr, wc, fr, fq); else m(acc, u, wr, wc, fr, fq); }
};
struct EpiInC {
    static constexpr bool PERM = true;
    bf16_t* Z; bf16_t* XR; bf16_t* BC; float* DT; const float* dt_bias;
    DEV void operator()(const f32x4 (&acc)[2][2][4][2], const pg8::Unit& u, int wr, int wc, int fr, int fq) const {
        const int row0 = u.pm * 256 + wr * 64 + fr, cin = wc * 32 + 8 * fq;
        if (u.pn == 20) {
            if (wc == 0) {
                const f32x4 b0 = *(const f32x4*)(dt_bias + 8 * fq), b1 = *(const f32x4*)(dt_bias + 8 * fq + 4);
#pragma unroll
                for (int ai = 0; ai < 2; ++ai)
#pragma unroll
                    for (int m = 0; m < 4; ++m) { float* rp = DT + (size_t)(row0 + ai * 128 + m * 16) * 32 + 8 * fq;
                        f32x4 v0 = acc[ai][0][m][0] + b0, v1 = acc[ai][0][m][1] + b1;
#pragma unroll
                        for (int j = 0; j < 4; ++j) { v0[j] = v0[j] > 20.f ? v0[j] : log1pf(__expf(v0[j])); v1[j] = v1[j] > 20.f ? v1[j] : log1pf(__expf(v1[j])); }
                        *(f32x4*)rp = v0; *(f32x4*)(rp + 4) = v1; }
            }
            return;
        }
        bf16_t* base; size_t ldc; int colt;
        if (u.pn < 8) { base = Z; ldc = 2048; colt = u.pn * 256; } else if (u.pn < 16) { base = XR; ldc = 2048; colt = (u.pn - 8) * 256; } else { base = BC; ldc = 1024; colt = (u.pn - 16) * 256; }
#pragma unroll
        for (int ai = 0; ai < 2; ++ai)
#pragma unroll
            for (int m = 0; m < 4; ++m) { bf16_t* rowp = base + (size_t)(row0 + ai * 128 + m * 16) * ldc + colt + cin;
#pragma unroll
                for (int bj = 0; bj < 2; ++bj) { const f32x4 v0 = acc[ai][bj][m][0], v1 = acc[ai][bj][m][1];
                    u32x4 w; w.x = pk2(v0[0], v0[1]); w.y = pk2(v0[2], v0[3]); w.z = pk2(v1[0], v1[1]); w.w = pk2(v1[2], v1[3]);
                    *(u32x4*)(rowp + bj * 128) = w; } }
    }
};

DEV void transpose_item(const float* __restrict__ W, int N, bf16_t* WT, int ldk, int koff, int row_off, int mode, float* scr, int kb, int nb, int lane) {
    const int k0 = 64 * kb, n0 = 32 * nb;
#pragma unroll 8
    for (int i = 0; i < 32; ++i) { const int kk = 2 * i + (lane >> 5); scr[kk * 33 + (lane & 31)] = W[(size_t)(k0 + kk) * N + n0 + (lane & 31)]; }
    LDS_FENCE();
    const int c = lane & 7;
#pragma unroll
    for (int j = 0; j < 4; ++j) { const int nl = (lane >> 3) + 8 * j, n = n0 + nl; const float* s = scr + (8 * c) * 33 + nl;
        u32x4 o; o.x = pk2(s[0 * 33], s[1 * 33]); o.y = pk2(s[2 * 33], s[3 * 33]); o.z = pk2(s[4 * 33], s[5 * 33]); o.w = pk2(s[6 * 33], s[7 * 33]);
        const int row = (mode == 0) ? (row_off + n) : (8 * (n >> 2) + (n & 3) + (mode == 2 ? 4 : 0));
        *(u32x4*)(WT + (size_t)row * ldk + koff + k0 + 8 * c) = o; }
    LDS_FENCE();
}
DEV void convert_weight(const float* W, int K, int N, bf16_t* WT, int ldk, int koff, int row_off, int mode, float* scr, int gw, int NGW, int lane, int& rot) {
    const int nblk = N / 32, items = (K / 64) * nblk;
    for (int it = (gw + NGW - (rot % NGW)) % NGW; it < items; it += NGW) transpose_item(W, N, WT, ldk, koff, row_off, mode, scr, it / nblk, it % nblk, lane);
    rot += items;
}
DEV void rms_row_bf16(const float* xrow, const float* g, bf16_t* orow, int lane) {
    f32x4 v[4]; float ss = 0.f;
#pragma unroll
    for (int j = 0; j < 4; ++j) { v[j] = *(const f32x4*)(xrow + (64 * j + lane) * 4); ss += (v[j][0] * v[j][0] + v[j][1] * v[j][1]) + (v[j][2] * v[j][2] + v[j][3] * v[j][3]); }
    const float rstd = rsqrtf(wave_sum(ss) * (1.f / 1024.f) + EPS);
#pragma unroll
    for (int j = 0; j < 4; ++j) { const f32x4 gg = *(const f32x4*)(g + (64 * j + lane) * 4);
        u32x2 o; o.x = pk2(v[j][0] * rstd * gg[0], v[j][1] * rstd * gg[1]); o.y = pk2(v[j][2] * rstd * gg[2], v[j][3] * rstd * gg[3]);
        *(u32x2*)(orow + (64 * j + lane) * 4) = o; }
}
DEV void rms_phase(const float* X, const float* g, bf16_t* H, int gw, int NGW, int lane, int T = ::T) {
    f32x4 gg[4];
#pragma unroll
    for (int j = 0; j < 4; ++j) gg[j] = *(const f32x4*)(g + (64 * j + lane) * 4);
    for (int t = gw; t < T; t += 2 * NGW) {
        const int t2 = t + NGW; const bool two = t2 < T; const int tb_ = two ? t2 : t;
        f32x4 v[4], u[4]; float sa = 0.f, sb = 0.f;
#pragma unroll
        for (int j = 0; j < 4; ++j) { v[j] = *(const f32x4*)(X + (size_t)t * 1024 + (64 * j + lane) * 4); u[j] = *(const f32x4*)(X + (size_t)tb_ * 1024 + (64 * j + lane) * 4); }
#pragma unroll
        for (int j = 0; j < 4; ++j) { sa += (v[j][0] * v[j][0] + v[j][1] * v[j][1]) + (v[j][2] * v[j][2] + v[j][3] * v[j][3]); sb += (u[j][0] * u[j][0] + u[j][1] * u[j][1]) + (u[j][2] * u[j][2] + u[j][3] * u[j][3]); }
#pragma unroll
        for (int o = 1; o < 64; o <<= 1) { sa += __shfl_xor(sa, o); sb += __shfl_xor(sb, o); }
        const float ra = rsqrtf(sa * (1.f / 1024.f) + EPS), rb = rsqrtf(sb * (1.f / 1024.f) + EPS);
#pragma unroll
        for (int j = 0; j < 4; ++j) { u32x2 o; o.x = pk2(v[j][0] * ra * gg[j][0], v[j][1] * ra * gg[j][1]); o.y = pk2(v[j][2] * ra * gg[j][2], v[j][3] * ra * gg[j][3]);
            *(u32x2*)(H + (size_t)t * 1024 + (64 * j + lane) * 4) = o; }
        if (two) {
#pragma unroll
            for (int j = 0; j < 4; ++j) { u32x2 o; o.x = pk2(u[j][0] * rb * gg[j][0], u[j][1] * rb * gg[j][1]); o.y = pk2(u[j][2] * rb * gg[j][2], u[j][3] * rb * gg[j][3]);
                *(u32x2*)(H + (size_t)tb_ * 1024 + (64 * j + lane) * 4) = o; } }
    }
}

DEV void phase0(const Params& p, unsigned char* ldsg, int gw, int NGW, int lane, int wave) {
    unsigned char* ws = p.ws; unsigned char* ob = (unsigned char*)p.out;
    float* scr = (float*)(ldsg + wave * 8448);
    int rot = 0;
    convert_weight(p.in[10], 1024, 1184, (bf16_t*)(ws + W_INAB), 1024, 0, 0, 0, scr, gw, NGW, lane, rot);
#pragma unroll 1
    for (int g = 0; g < 4; ++g) convert_weight(p.in[11] + g * 16384, 128, 128, (bf16_t*)(ws + W_POOL), 512, g * 128, g * 128, 0, scr, gw, NGW, lane, rot);
    convert_weight(p.in[14], 384, 768, (bf16_t*)(ws + W_UQ), 384, 0, 0, 0, scr, gw, NGW, lane, rot);
    convert_weight(p.in[16], 256, 512, (bf16_t*)(ws + W_UK), 256, 0, 0, 0, scr, gw, NGW, lane, rot);
    convert_weight(p.in[17], 256, 512, (bf16_t*)(ws + W_UV), 256, 0, 0, 0, scr, gw, NGW, lane, rot);
    const int gt = gw * 64 + lane, NGT = NGW * 64;
    const u32x4 z4 = {0u, 0u, 0u, 0u};
    for (int i = gt; i < 12288; i += NGT) *(u32x4*)(ws + W_INAB + (size_t)1184 * 2048 + (size_t)i * 16) = z4;
    for (int i = gt; i < 32768; i += NGT) { const int row = i >> 6, col = (i & 63) * 8; if ((row >> 7) != (col >> 7)) *(u32x4*)(ws + W_POOL + (size_t)i * 16) = z4; }
    { f32x4 gg[4];
#pragma unroll
      for (int j = 0; j < 4; ++j) gg[j] = *(const f32x4*)(p.in[7] + (64 * j + lane) * 4);
      bf16_t* H = (bf16_t*)(ws + H0);
      for (int t = gw; t < T; t += 2 * NGW) {
        const int t2 = t + NGW; const bool two = t2 < T; const int tb_ = two ? t2 : t;
        const float* xa = t < TPR ? p.in[0] + (size_t)t * 1024 : p.in[1] + (size_t)(t - TPR) * 1024;
        const float* xb = tb_ < TPR ? p.in[0] + (size_t)tb_ * 1024 : p.in[1] + (size_t)(tb_ - TPR) * 1024;
        f32x4 v[4], u[4]; float sa = 0.f, sb = 0.f;
#pragma unroll
        for (int j = 0; j < 4; ++j) { v[j] = *(const f32x4*)(xa + (64 * j + lane) * 4); u[j] = *(const f32x4*)(xb + (64 * j + lane) * 4); }
#pragma unroll
        for (int j = 0; j < 4; ++j) { sa += (v[j][0] * v[j][0] + v[j][1] * v[j][1]) + (v[j][2] * v[j][2] + v[j][3] * v[j][3]); sb += (u[j][0] * u[j][0] + u[j][1] * u[j][1]) + (u[j][2] * u[j][2] + u[j][3] * u[j][3]); }
#pragma unroll
        for (int o = 1; o < 64; o <<= 1) { sa += __shfl_xor(sa, o); sb += __shfl_xor(sb, o); }
        const float ra = rsqrtf(sa * (1.f / 1024.f) + EPS), rb = rsqrtf(sb * (1.f / 1024.f) + EPS);
#pragma unroll
        for (int j = 0; j < 4; ++j) { u32x2 o; o.x = pk2(v[j][0] * ra * gg[j][0], v[j][1] * ra * gg[j][1]); o.y = pk2(v[j][2] * ra * gg[j][2], v[j][3] * ra * gg[j][3]);
            *(u32x2*)(H + (size_t)t * 1024 + (64 * j + lane) * 4) = o; }
        if (two) {
#pragma unroll
            for (int j = 0; j < 4; ++j) { u32x2 o; o.x = pk2(u[j][0] * rb * gg[j][0], u[j][1] * rb * gg[j][1]); o.y = pk2(u[j][2] * rb * gg[j][2], u[j][3] * rb * gg[j][3]);
                *(u32x2*)(H + (size_t)tb_ * 1024 + (64 * j + lane) * 4) = o; } }
      } }
    bf16_t* ckv_all = (bf16_t*)(ob + D_CKVALL); bf16_t* kpe_all = (bf16_t*)(ob + D_KPEALL);
    for (int r0 = gw; r0 < 65536; r0 += 8 * NGW) {
        f32x4 v[8];
#pragma unroll
        for (int k = 0; k < 8; ++k) { const int r = r0 + k * NGW; v[k] = *(const f32x4*)(p.in[2] + (size_t)(r < 65536 ? r : r0) * 256 + lane * 4); }
#pragma unroll
        for (int k = 0; k < 8; ++k) { const int r = r0 + k * NGW; if (r < 65536) { const int b = r >> 12, j = r & 4095;
            u32x2 o; o.x = pk2(v[k][0], v[k][1]); o.y = pk2(v[k][2], v[k][3]); *(u32x2*)(ckv_all + (size_t)(TPR + b * SKV + j) * 256 + lane * 4) = o; } }
    }
    for (int i0 = gt; i0 < 65536 * 8; i0 += 4 * NGT) {
        f32x4 v[4];
#pragma unroll
        for (int k = 0; k < 4; ++k) { const int i = i0 + k * NGT; const int ii = i < 65536 * 8 ? i : i0; v[k] = *(const f32x4*)(p.in[3] + (size_t)(ii >> 3) * 32 + (ii & 7) * 4); }
#pragma unroll
        for (int k = 0; k < 4; ++k) { const int i = i0 + k * NGT; if (i < 65536 * 8) { const int r = i >> 3, c = (i & 7) * 4, b = r >> 12, j = r & 4095;
            u32x2 o; o.x = pk2(v[k][0], v[k][1]); o.y = pk2(v[k][2], v[k][3]); *(u32x2*)(kpe_all + (size_t)(TPR + b * SKV + j) * 32 + c) = o; } }
    }
    float* rope = (float*)(ob + D_ROPE);
    for (int i = gt; i < 16400 * 16; i += NGT) { const int pidx = i >> 4, k = i & 15; const int pos = pidx < TPR ? pidx : 4096 + (pidx - TPR);
        const float inv = powf(10000.0f, -(float)k / 16.0f); const float ang = (float)pos * inv;
        double rev = (double)ang * 0.15915494309189535; rev -= floor(rev); const float fr = (float)rev;
        rope[pidx * 32 + k] = __builtin_amdgcn_cosf(fr); rope[pidx * 32 + 16 + k] = __builtin_amdgcn_sinf(fr); }
}

struct P2Loads { bf16x8 nb[16]; bf16x8 qraw, kvraw; float rx1, rx2, rcs, rsn; };
DEV void p2_load(const Params& p, int t, int lane, P2Loads& L) {
    const bf16_t* proj = (const bf16_t*)(p.ws + PROJ); const float* rope = (const float*)((unsigned char*)p.out + D_ROPE);
    const bool prm = t < TPR; const int r = t - TPR, b = prm ? 0 : (r >> 4), s = prm ? t : (r & 15);
    const bf16_t* pr = proj + (size_t)t * 1280;
    const bf16x8 z8 = {0, 0, 0, 0, 0, 0, 0, 0};
    const int c0 = lane * 8, w = 2 << (lane >> 4);
#pragma unroll
    for (int i = 0; i < 16; ++i) { const int sp = s - i;
        if (i >= w) L.nb[i] = z8;
        else if (sp >= 0) L.nb[i] = *(const bf16x8*)(pr - (size_t)i * 1280 + c0);
        else if (!prm) { const float* hp = p.in[4] + ((size_t)b * 15 + (15 + sp)) * 512 + c0; const f32x4 a = *(const f32x4*)hp, c = *(const f32x4*)(hp + 4);
            u32x4 q; q.x = pk2(a[0], a[1]); q.y = pk2(a[2], a[3]); q.z = pk2(c[0], c[1]); q.w = pk2(c[2], c[3]); L.nb[i] = __builtin_bit_cast(bf16x8, q); }
        else L.nb[i] = z8; }
    L.qraw = lane < 48 ? *(const bf16x8*)(pr + 512 + lane * 8) : z8;
    L.kvraw = lane < 32 ? *(const bf16x8*)(pr + 896 + lane * 8) : z8;
    const int l16 = lane & 15, pidx_ = prm ? t : TPR + s;
    L.rx1 = bf2f((short)pr[1152 + l16]); L.rx2 = bf2f((short)pr[1168 + l16]); L.rcs = rope[pidx_ * 32 + l16]; L.rsn = rope[pidx_ * 32 + 16 + l16];
}
DEV void phase2(const Params& p, int gw, int NGW, int lane) {
    unsigned char* ws = p.ws; unsigned char* ob = (unsigned char*)p.out; float* out = p.out;
    bf16_t* pooled = (bf16_t*)(ws + POOLED); bf16_t* qln = (bf16_t*)(ws + QLN);
    bf16_t* ckv_all = (bf16_t*)(ob + D_CKVALL); bf16_t* kpe_all = (bf16_t*)(ob + D_KPEALL);
    f32x4 gq0 = {0.f, 0.f, 0.f, 0.f}, gq1 = gq0, gk0 = gq0, gk1 = gq0;
    if (lane < 48) { gq0 = *(const f32x4*)(p.in[13] + lane * 8); gq1 = *(const f32x4*)(p.in[13] + lane * 8 + 4); }
    if (lane < 32) { gk0 = *(const f32x4*)(p.in[15] + lane * 8); gk1 = *(const f32x4*)(p.in[15] + lane * 8 + 4); }
    P2Loads L;
    if (gw < T) p2_load(p, gw, lane, L);
    for (int t = gw; t < T; t += NGW) {
        const bool prm = t < TPR; const int r = t - TPR, b = prm ? 0 : (r >> 4), s = prm ? t : (r & 15), pos = prm ? t : 4096 + s;
        const P2Loads C = L;
        if (t + NGW < T) p2_load(p, t + NGW, lane, L);
        {
            const int c0 = lane * 8, w = 2 << (lane >> 4);
            float sum[8], sf[8];
#pragma unroll
            for (int e = 0; e < 8; ++e) { sf[e] = bf2f(C.nb[0][e]); sum[e] = sf[e]; }
#pragma unroll
            for (int i = 1; i < 16; ++i)
#pragma unroll
                for (int e = 0; e < 8; ++e) sum[e] += bf2f(C.nb[i][e]);
            const float rc = 1.0f / (float)(pos + 1 < w ? pos + 1 : w);
            u32x4 o; o.x = pk2(sum[0] * rc - sf[0], sum[1] * rc - sf[1]); o.y = pk2(sum[2] * rc - sf[2], sum[3] * rc - sf[3]);
            o.z = pk2(sum[4] * rc - sf[4], sum[5] * rc - sf[5]); o.w = pk2(sum[6] * rc - sf[6], sum[7] * rc - sf[7]);
            *(u32x4*)(pooled + (size_t)t * 512 + c0) = o;
            float* np = nullptr;
            if (prm) { if (t >= TPR - 15) np = out + O_POOLP + (size_t)(t - (TPR - 15)) * 512 + c0; }
            else if (s >= 1) np = out + O_POOLS + ((size_t)b * 15 + (s - 1)) * 512 + c0;
            if (np) { *(f32x4*)np = (f32x4){sf[0], sf[1], sf[2], sf[3]}; *(f32x4*)(np + 4) = (f32x4){sf[4], sf[5], sf[6], sf[7]}; }
        }
        float vq[8], vk[8]; float sq = 0.f, sk = 0.f;
#pragma unroll
        for (int e = 0; e < 8; ++e) { vq[e] = bf2f(C.qraw[e]); sq += vq[e] * vq[e]; vk[e] = bf2f(C.kvraw[e]); sk += vk[e] * vk[e]; }
#pragma unroll
        for (int o = 1; o < 64; o <<= 1) { sq += __shfl_xor(sq, o); sk += __shfl_xor(sk, o); }
        const float rq = rsqrtf(sq * (1.f / 384.f) + EPS), rk = rsqrtf(sk * (1.f / 256.f) + EPS);
        if (lane < 48) {
            u32x4 o; o.x = pk2(vq[0] * rq * gq0[0], vq[1] * rq * gq0[1]); o.y = pk2(vq[2] * rq * gq0[2], vq[3] * rq * gq0[3]);
            o.z = pk2(vq[4] * rq * gq1[0], vq[5] * rq * gq1[1]); o.w = pk2(vq[6] * rq * gq1[2], vq[7] * rq * gq1[3]);
            *(u32x4*)(qln + (size_t)t * 384 + lane * 8) = o; }
        const size_t krow = prm ? (size_t)t : (size_t)(TPR + b * SKV + 4096 + s);
        if (lane < 32) {
            f32x4 o0 = {vk[0] * rk * gk0[0], vk[1] * rk * gk0[1], vk[2] * rk * gk0[2], vk[3] * rk * gk0[3]};
            f32x4 o1 = {vk[4] * rk * gk1[0], vk[5] * rk * gk1[1], vk[6] * rk * gk1[2], vk[7] * rk * gk1[3]};
            float* op = (prm ? out + O_CKVP + (size_t)t * 256 : out + O_CKVS + (size_t)r * 256) + lane * 8;
            *(f32x4*)op = o0; *(f32x4*)(op + 4) = o1;
            u32x4 o; o.x = pk2(o0[0], o0[1]); o.y = pk2(o0[2], o0[3]); o.z = pk2(o1[0], o1[1]); o.w = pk2(o1[2], o1[3]);
            *(u32x4*)(ckv_all + krow * 256 + lane * 8) = o; }
        if (lane < 16) {
            const float x1 = C.rx1, x2 = C.rx2, cs = C.rcs, sn = C.rsn;
            const float o1 = x1 * cs - x2 * sn, o2 = x2 * cs + x1 * sn;
            float* op = prm ? out + O_KPEP + (size_t)t * 32 : out + O_KPES + (size_t)r * 32;
            op[lane] = o1; op[16 + lane] = o2;
            kpe_all[krow * 32 + lane] = (bf16_t)(pk2(o1, 0.f) & 0xffffu); kpe_all[krow * 32 + 16 + lane] = (bf16_t)(pk2(o2, 0.f) & 0xffffu);
        }
    }
}

struct AttnPtrs { const bf16_t* Q; const bf16_t* KN; const bf16_t* KPE; const bf16_t* VT; const float* rope; bf16_t* cat; };

DEV void load_q(const AttnPtrs& A, size_t trow, int h, int pidx, int hi, bf16x8 (&qf)[6]) {
    const bf16_t* qp = A.Q + trow * 768 + h * 96 + hi * 8;
#pragma unroll
    for (int ks = 0; ks < 6; ++ks) qf[ks] = *(const bf16x8*)(qp + ks * 16);
    const float* rp = A.rope + pidx * 32 + hi * 8;
    const f32x4 c0 = *(const f32x4*)rp, c1 = *(const f32x4*)(rp + 4), s0 = *(const f32x4*)(rp + 16), s1 = *(const f32x4*)(rp + 20);
    float x1[8], x2[8], o1[8], o2[8];
#pragma unroll
    for (int j = 0; j < 8; ++j) { x1[j] = bf2f(qf[4][j]); x2[j] = bf2f(qf[5][j]); const float cs = j < 4 ? c0[j & 3] : c1[j & 3], sn = j < 4 ? s0[j & 3] : s1[j & 3];
        o1[j] = (x1[j] * cs - x2[j] * sn) * QSCALE; o2[j] = (x2[j] * cs + x1[j] * sn) * QSCALE; }
    u32x4 a, b; a.x = pk2(o1[0], o1[1]); a.y = pk2(o1[2], o1[3]); a.z = pk2(o1[4], o1[5]); a.w = pk2(o1[6], o1[7]);
    b.x = pk2(o2[0], o2[1]); b.y = pk2(o2[2], o2[3]); b.z = pk2(o2[4], o2[5]); b.w = pk2(o2[6], o2[7]);
    qf[4] = __builtin_bit_cast(bf16x8, a); qf[5] = __builtin_bit_cast(bf16x8, b);
#pragma unroll
    for (int ks = 0; ks < 4; ++ks) { u32x4 w;
        w.x = pk2(bf2f(qf[ks][0]) * QSCALE, bf2f(qf[ks][1]) * QSCALE); w.y = pk2(bf2f(qf[ks][2]) * QSCALE, bf2f(qf[ks][3]) * QSCALE);
        w.z = pk2(bf2f(qf[ks][4]) * QSCALE, bf2f(qf[ks][5]) * QSCALE); w.w = pk2(bf2f(qf[ks][6]) * QSCALE, bf2f(qf[ks][7]) * QSCALE);
        qf[ks] = __builtin_bit_cast(bf16x8, w); }
}
DEV void softmax_update(f32x16 (&s)[2], float& m, float& l, f32x16 (&o)[2]) {
    float mx = s[0][0];
#pragma unroll
    for (int i = 1; i < 16; ++i) mx = fmaxf(mx, s[0][i]);
#pragma unroll
    for (int i = 0; i < 16; ++i) mx = fmaxf(mx, s[1][i]);
    mx = fmaxf(mx, __shfl_xor(mx, 32));
    if (__any(mx - m > 8.0f)) {
        const float mn = fmaxf(m, mx), alpha = __builtin_amdgcn_exp2f(m - mn);
        m = mn; l *= alpha; o[0] *= alpha; o[1] *= alpha;
    }
    float sum = 0.f;
#pragma unroll
    for (int i = 0; i < 16; ++i) { s[0][i] = __builtin_amdgcn_exp2f(s[0][i] - m); s[1][i] = __builtin_amdgcn_exp2f(s[1][i] - m); sum += s[0][i] + s[1][i]; }
    l += sum;
}

constexpr int KS_STRIDE = 104, VS_STRIDE = 68, KS_BYTES = 64 * KS_STRIDE * 2, VS_BYTES = 64 * VS_STRIDE * 2;

DEV void attn_qk(const bf16_t* K, const bf16x8 (&qf)[6], int l32, int hi, f32x16 (&s)[2]) {
    bf16x8 kf[6][2];
#pragma unroll
    for (int ks = 0; ks < 6; ++ks)
#pragma unroll
        for (int st = 0; st < 2; ++st) kf[ks][st] = *(const bf16x8*)(K + (32 * st + l32) * KS_STRIDE + 16 * ks + hi * 8);
    __builtin_amdgcn_sched_barrier(0);
    s[0] = zero16(); s[1] = zero16();
#pragma unroll
    for (int ks = 0; ks < 6; ++ks)
#pragma unroll
        for (int st = 0; st < 2; ++st) s[st] = mfma32(kf[ks][st], qf[ks], s[st]);
}
DEV void attn_pv(const bf16_t* V, const f32x16 (&s)[2], int l32, int hi, f32x16 (&o)[2]) {
    bf16x8 vf[4][2];
#pragma unroll
    for (int ks = 0; ks < 4; ++ks)
#pragma unroll
        for (int dt = 0; dt < 2; ++dt) { const bf16_t* vp = V + (32 * dt + l32) * VS_STRIDE + 16 * ks + hi * 4; vf[ks][dt] = cat4(*(const s16x4*)vp, *(const s16x4*)(vp + 8)); }
    bf16x8 pb[4]; pb[0] = pack8<0>(s[0]); pb[1] = pack8<8>(s[0]); pb[2] = pack8<0>(s[1]); pb[3] = pack8<8>(s[1]);
    __builtin_amdgcn_sched_barrier(0);
#pragma unroll
    for (int ks = 0; ks < 4; ++ks)
#pragma unroll
        for (int dt = 0; dt < 2; ++dt) o[dt] = mfma32(vf[ks][dt], pb[ks], o[dt]);
}
constexpr int VS2_STRIDE = 132, K2_TILE = 128 * KS_STRIDE, V2_TILE = 64 * VS2_STRIDE;
DEV void attn_pv2(const bf16_t* V, const f32x16 (&s)[2], int l32, int hi, f32x16 (&o)[2]) {
    bf16x8 vf[4][2];
#pragma unroll
    for (int ks = 0; ks < 4; ++ks)
#pragma unroll
        for (int dt = 0; dt < 2; ++dt) { const bf16_t* vp = V + (32 * dt + l32) * VS2_STRIDE + 16 * ks + hi * 4; vf[ks][dt] = cat4(*(const s16x4*)vp, *(const s16x4*)(vp + 8)); }
    bf16x8 pb[4]; pb[0] = pack8<0>(s[0]); pb[1] = pack8<8>(s[0]); pb[2] = pack8<0>(s[1]); pb[3] = pack8<8>(s[1]);
    __builtin_amdgcn_sched_barrier(0);
#pragma unroll
    for (int ks = 0; ks < 4; ++ks)
#pragma unroll
        for (int dt = 0; dt < 2; ++dt) o[dt] = mfma32(vf[ks][dt], pb[ks], o[dt]);
}
DEV void attn_prompt_unit(const AttnPtrs& A, unsigned char* ldsg, int h, int qb) {
    const int tid = otid(), lane = tid & 63, w = tid >> 6, l32 = lane & 31, hi = lane >> 5;
    const int qrow = qb * 256 + w * 32 + l32;
    bf16x8 qf[6]; load_q(A, (size_t)qrow, h, qrow, hi, qf);
    f32x16 o[2]; o[0] = zero16(); o[1] = zero16(); float m = -1e30f, l = 0.f;
    const int nt2 = 2 * qb + 2, wlim = 4 * qb + (w >> 1);
    bf16_t* Ks = (bf16_t*)ldsg; bf16_t* Vs = (bf16_t*)(ldsg + 3 * K2_TILE * 2);
    const int skey = tid >> 3, sc = tid & 7, rkey = tid >> 2, rc = tid & 3, vd = tid >> 4, vc = tid & 15;
    const bf16_t* kn_src = A.KN + (size_t)skey * 512 + h * 64 + sc * 8;
    const bf16_t* kr_src = A.KPE + (size_t)rkey * 32 + rc * 8;
    const bf16_t* v_src = A.VT + (size_t)(h * 64 + vd) * NK + vc * 8;
    const int kdst = skey * KS_STRIDE + sc * 8, rdst = rkey * KS_STRIDE + 64 + rc * 8, vdst = vd * VS2_STRIDE + vc * 8;
#define ST_K(buf, a, b, c) do { bf16_t* K_ = Ks + (buf) * K2_TILE; *(u32x4*)(K_ + kdst) = (a); *(u32x4*)(K_ + kdst + 64 * KS_STRIDE) = (b); *(u32x4*)(K_ + rdst) = (c); } while (0)
#define ST_V(buf, a, b) do { bf16_t* V_ = Vs + (buf) * V2_TILE; *(u32x2*)(V_ + vdst) = (u32x2){(a).x, (a).y}; *(u32x2*)(V_ + vdst + 4) = (u32x2){(a).z, (a).w}; \
        *(u32x2*)(V_ + vdst + 32 * VS2_STRIDE) = (u32x2){(b).x, (b).y}; *(u32x2*)(V_ + vdst + 32 * VS2_STRIDE + 4) = (u32x2){(b).z, (b).w}; } while (0)
    {
        u32x4 a = *(const u32x4*)kn_src, b = *(const u32x4*)(kn_src + 64 * 512), c = *(const u32x4*)kr_src;
        u32x4 d = *(const u32x4*)(kn_src + 128 * 512), e = *(const u32x4*)(kn_src + 192 * 512), f = *(const u32x4*)(kr_src + 128 * 32);
        u32x4 g = *(const u32x4*)v_src, hh = *(const u32x4*)(v_src + (size_t)32 * NK);
        ST_K(0, a, b, c); ST_K(1, d, e, f); ST_V(0, g, hh);
    }
    __syncthreads();
    f32x16 s[2]; attn_qk(Ks, qf, l32, hi, s);
    int k3 = 0;
    for (int kt = 0; kt < nt2; ++kt) {
        const int k3n = k3 == 2 ? 0 : k3 + 1, k3nn = k3n == 2 ? 0 : k3n + 1;
        u32x4 rk0, rk1, rr, rv0, rv1;
        const bool pk_ = kt + 2 < nt2, pv_ = kt + 1 < nt2;
        if (pk_) { const size_t k0 = (size_t)(kt + 2) * 128; rk0 = *(const u32x4*)(kn_src + k0 * 512); rk1 = *(const u32x4*)(kn_src + (k0 + 64) * 512); rr = *(const u32x4*)(kr_src + k0 * 32); }
        if (pv_) { const size_t k0 = (size_t)(kt + 1) * 128; rv0 = *(const u32x4*)(v_src + k0); rv1 = *(const u32x4*)(v_src + (size_t)32 * NK + k0); }
#pragma unroll
        for (int j = 0; j < 2; ++j) {
            if (2 * kt + j <= wlim) {
                const bf16_t* Kn = (j == 0) ? Ks + k3 * K2_TILE + 64 * KS_STRIDE : Ks + k3n * K2_TILE;
                const bf16_t* V = Vs + (kt & 1) * V2_TILE + 64 * j;
                f32x16 sn[2];
                if (w < 4) {
                    attn_qk(Kn, qf, l32, hi, sn);
                    __builtin_amdgcn_sched_barrier(0);
                    softmax_update(s, m, l, o);
                    attn_pv2(V, s, l32, hi, o);
                } else {
                    softmax_update(s, m, l, o);
                    attn_pv2(V, s, l32, hi, o);
                    __builtin_amdgcn_sched_barrier(0);
                    attn_qk(Kn, qf, l32, hi, sn);
                }
                s[0] = sn[0]; s[1] = sn[1];
            }
        }
        if (pk_) ST_K(k3nn, rk0, rk1, rr);
        if (pv_) ST_V((kt + 1) & 1, rv0, rv1);
        __syncthreads();
        k3 = k3n;
    }
#undef ST_K
#undef ST_V
    const float lt = l + __shfl_xor(l, 32), rl = 1.0f / lt;
    bf16_t* op = A.cat + (size_t)qrow * 1024 + 512 + h * 64 + 4 * hi;
#pragma unroll
    for (int dt = 0; dt < 2; ++dt)
#pragma unroll
        for (int g = 0; g < 4; ++g) { u32x2 v; v.x = pk2(o[dt][4 * g] * rl, o[dt][4 * g + 1] * rl); v.y = pk2(o[dt][4 * g + 2] * rl, o[dt][4 * g + 3] * rl);
            *(u32x2*)(op + 32 * dt + 8 * g) = v; }
}

DEV void attn_sample_unit(const AttnPtrs& A, unsigned char* ldsg, int b, int h) {
    const int tid = otid(), lane = tid & 63, w = tid >> 6, l32 = lane & 31, hi = lane >> 5;
    const int s_ = l32 < 16 ? l32 : 15;
    bf16x8 qf[6]; load_q(A, (size_t)(TPR + b * 16 + s_), h, TPR + s_, hi, qf);
    f32x16 o[2]; o[0] = zero16(); o[1] = zero16(); float m = -1e30f, l = 0.f;
    const size_t base = (size_t)TPR + (size_t)b * SKV;
    bf16x8 kn[2][6];
#define SA_LOADK(dst, kt_) do { _Pragma("unroll") for (int st = 0; st < 2; ++st) { int key = (kt_) * 64 + 32 * st + l32; key = key < SKV ? key : SKV - 1; const size_t row = base + key; \
        const bf16_t* kp = A.KN + row * 512 + h * 64 + hi * 8; const bf16_t* rp = A.KPE + row * 32 + hi * 8; \
        _Pragma("unroll") for (int ks = 0; ks < 4; ++ks) dst[st][ks] = *(const bf16x8*)(kp + 16 * ks); \
        _Pragma("unroll") for (int ks = 0; ks < 2; ++ks) dst[st][4 + ks] = *(const bf16x8*)(rp + 16 * ks); } } while (0)
    SA_LOADK(kn, w);
    for (int kt = w; kt < 65; kt += 8) {
        bf16x8 kf[2][6];
#pragma unroll
        for (int st = 0; st < 2; ++st)
#pragma unroll
            for (int ks = 0; ks < 6; ++ks) kf[st][ks] = kn[st][ks];
        bf16x8 vf[4][2];
#pragma unroll
        for (int ks = 0; ks < 4; ++ks)
#pragma unroll
            for (int dt = 0; dt < 2; ++dt) { const bf16_t* vp = A.VT + (size_t)(h * 64 + 32 * dt + l32) * NK + base + kt * 64 + 16 * ks + hi * 4; vf[ks][dt] = cat4(*(const s16x4*)vp, *(const s16x4*)(vp + 8)); }
        if (kt + 8 < 65) SA_LOADK(kn, kt + 8);
        f32x16 s[2]; s[0] = zero16(); s[1] = zero16();
#pragma unroll
        for (int ks = 0; ks < 6; ++ks)
#pragma unroll
            for (int st = 0; st < 2; ++st) s[st] = mfma32(kf[st][ks], qf[ks], s[st]);
        if (kt == 64) {
#pragma unroll
            for (int st = 0; st < 2; ++st)
#pragma unroll
                for (int i = 0; i < 16; ++i) { const int key = 4096 + 32 * st + 8 * (i >> 2) + 4 * hi + (i & 3); if (key >= SKV) s[st][i] = -1e30f; }
        }
        softmax_update(s, m, l, o);
        bf16x8 pb[4]; pb[0] = pack8<0>(s[0]); pb[1] = pack8<8>(s[0]); pb[2] = pack8<0>(s[1]); pb[3] = pack8<8>(s[1]);
#pragma unroll
        for (int ks = 0; ks < 4; ++ks)
#pragma unroll
            for (int dt = 0; dt < 2; ++dt) o[dt] = mfma32(vf[ks][dt], pb[ks], o[dt]);
    }
#undef SA_LOADK
    float* cm = (float*)ldsg; float* cl = cm + 256; float* cO = cl + 256;
    const float lt = l + __shfl_xor(l, 32);
    if (hi == 0) { cm[w * 32 + l32] = m; cl[w * 32 + l32] = lt; }
#pragma unroll
    for (int dt = 0; dt < 2; ++dt)
#pragma unroll
        for (int i = 0; i < 16; ++i) cO[(w * 64 + 32 * dt + 8 * (i >> 2) + 4 * hi + (i & 3)) * 32 + l32] = o[dt][i];
    __syncthreads();
    for (int idx = tid; idx < 1024; idx += 512) { const int q = idx & 15, d = idx >> 4;
        float M = cm[q];
#pragma unroll
        for (int ww = 1; ww < 8; ++ww) M = fmaxf(M, cm[ww * 32 + q]);
        float num = 0.f, den = 0.f;
#pragma unroll
        for (int ww = 0; ww < 8; ++ww) { const float f = __builtin_amdgcn_exp2f(cm[ww * 32 + q] - M); num += cO[(ww * 64 + d) * 32 + q] * f; den += cl[ww * 32 + q] * f; }
        A.cat[(size_t)(TPR + b * 16 + q) * 1024 + 512 + h * 64 + d] = (bf16_t)(pk2(num / den, 0.f) & 0xffffu); }
    __syncthreads();
}

template <bool IS_X>
DEV void conv_load(const Params& p, int tid, int tt, int ct, bf16x8 (&xr)[4][4]) {
    const int ti = tid >> 3, cg8 = tid & 7, t = tt * 64 + ti, ld = IS_X ? 2048 : 1024;
    const bf16_t* raw = (const bf16_t*)(p.ws + (IS_X ? XRAW : BCRAW));
    const bool prm = t < TPR; const int r = t - TPR, b = prm ? 0 : (r >> 4), s = prm ? t : (r & 15);
    const bf16x8 z8 = {0, 0, 0, 0, 0, 0, 0, 0};
#pragma unroll
    for (int q = 0; q < 4; ++q) {
        const int cc = ct * 256 + q * 64 + cg8 * 8, ch = IS_X ? cc : 2048 + cc;
#pragma unroll
        for (int j = 0; j < 4; ++j) {
            const int sp = s - 3 + j;
            if (sp >= 0) xr[q][j] = *(const bf16x8*)(raw + (size_t)(t - 3 + j) * ld + cc);
            else if (!prm) { const float* hp = p.in[5] + ((size_t)b * 3 + (3 + sp)) * 3072 + ch; const f32x4 a = *(const f32x4*)hp, c = *(const f32x4*)(hp + 4);
                u32x4 w; w.x = pk2(a[0], a[1]); w.y = pk2(a[2], a[3]); w.z = pk2(c[0], c[1]); w.w = pk2(c[2], c[3]); xr[q][j] = __builtin_bit_cast(bf16x8, w); }
            else xr[q][j] = z8;
        }
    }
}
template <bool IS_X>
DEV void conv_phase(const Params& p, unsigned char* ldsg, int bid, int G, int unit = -1) {
    constexpr int NCT = IS_X ? 8 : 4, NITEMS = 260 * NCT;
    unsigned char* ws = p.ws; float* out = p.out;
    const int tid = otid(), ti = tid >> 3, cg8 = tid & 7;
    bf16_t* tile = (bf16_t*)ldsg;
    bf16x8 xr[4][4];
    const bool um = unit >= 0, uprm = unit < 256;
    const int uc = unit >> 2, ug = unit & 3, ub = (unit - 256) >> 2;
    const int nit = um ? (uprm ? 8 : 2) : (bid < NITEMS ? (NITEMS - 1 - bid) / G + 1 : 0);
#define CONV_MAP(k, tt_, ct_) do { if (um) { if (uprm) { tt_ = 4 * uc + ((k) >> 1); ct_ = 2 * ug + ((k) & 1); } else { tt_ = 256 + (ub >> 2); ct_ = 2 * ug + (k); } } \
        else { const int it_ = bid + (k) * G; tt_ = it_ / NCT; ct_ = it_ % NCT; } } while (0)
    if (nit > 0) { int tt0, ct0; CONV_MAP(0, tt0, ct0); conv_load<IS_X>(p, tid, tt0, ct0, xr); }
    for (int k = 0; k < nit; ++k) {
        int tt, ct; CONV_MAP(k, tt, ct);
        const int t = tt * 64 + ti;
        const bool prm = t < TPR; const int r = t - TPR, b = prm ? 0 : (r >> 4), s = prm ? t : (r & 15);
        const bool is_c = !IS_X && ct >= 2;
        u32x4 ov[4]; bf16x8 lastrow[4];
#pragma unroll
        for (int q = 0; q < 4; ++q) {
            const int cc = ct * 256 + q * 64 + cg8 * 8, ch = IS_X ? cc : 2048 + cc;
            float acc[8];
            { const f32x4 b0 = *(const f32x4*)(p.in[21] + ch), b1 = *(const f32x4*)(p.in[21] + ch + 4);
#pragma unroll
              for (int e = 0; e < 4; ++e) { acc[e] = b0[e]; acc[4 + e] = b1[e]; } }
#pragma unroll
            for (int j = 0; j < 4; ++j) {
                const f32x4 w0 = *(const f32x4*)(p.in[20] + j * 3072 + ch), w1 = *(const f32x4*)(p.in[20] + j * 3072 + ch + 4);
#pragma unroll
                for (int e = 0; e < 4; ++e) { acc[e] += w0[e] * bf2f(xr[q][j][e]); acc[4 + e] += w1[e] * bf2f(xr[q][j][4 + e]); }
            }
            lastrow[q] = xr[q][3];
            float y[8];
#pragma unroll
            for (int e = 0; e < 8; ++e) y[e] = silu(acc[e]);
            ov[q].x = pk2(y[0], y[1]); ov[q].y = pk2(y[2], y[3]); ov[q].z = pk2(y[4], y[5]); ov[q].w = pk2(y[6], y[7]);
            if (!is_c) { const bf16x8 o8 = __builtin_bit_cast(bf16x8, ov[q]);
                const int tk = ti & 15, pos = ((((tk >> 2) & 1) * 2 + (tk >> 3)) << 2) + (tk & 3);
                const int rowb = IS_X ? ((q * 4 + (ti >> 4)) * 64 + cg8 * 8) : (((q >> 1) * 4 + (ti >> 4)) * 128 + (q & 1) * 64 + cg8 * 8);
#pragma unroll
                for (int e = 0; e < 8; ++e) tile[(rowb + e) * 16 + pos] = (bf16_t)o8[e]; }
        }
        if (k + 1 < nit) { int tn, cn; CONV_MAP(k + 1, tn, cn); conv_load<IS_X>(p, tid, tn, cn, xr); }
#pragma unroll
        for (int q = 0; q < 4; ++q) {
            const int cc = ct * 256 + q * 64 + cg8 * 8, ch = IS_X ? cc : 2048 + cc;
            if (!IS_X) { if (!is_c) *(u32x4*)((bf16_t*)(ws + BN) + (size_t)t * 512 + cc) = ov[q]; else *(u32x4*)((bf16_t*)(ws + CN) + (size_t)t * 512 + (cc - 512)) = ov[q]; }
            float* np = nullptr;
            if (prm) { if (t >= TPR - 3) np = out + O_CONVP + (size_t)(t - (TPR - 3)) * 3072 + ch; }
            else if (s >= 13) np = out + O_CONVS + ((size_t)b * 3 + (s - 13)) * 3072 + ch;
            if (np) { const bf16x8 l8 = lastrow[q]; *(f32x4*)np = (f32x4){bf2f(l8[0]), bf2f(l8[1]), bf2f(l8[2]), bf2f(l8[3])}; *(f32x4*)(np + 4) = (f32x4){bf2f(l8[4]), bf2f(l8[5]), bf2f(l8[6]), bf2f(l8[7])}; }
        }
        if (!is_c) {
            __syncthreads();
            if (IS_X) {
#pragma unroll
                for (int q = 0; q < 4; ++q) { const u32x4 tv = *(const u32x4*)(tile + q * 4096 + tid * 8);
                    *(u32x4*)((bf16_t*)(ws + XTB) + ((size_t)(ct * 4 + q) * NTB + tt * 4) * 1024 + tid * 8) = tv; }
            } else {
#pragma unroll
                for (int q = 0; q < 4; ++q) { const int g2 = q >> 1, cidx = (q & 1) * 512 + tid; const u32x4 tv = *(const u32x4*)(tile + g2 * 8192 + cidx * 8);
                    *(u32x4*)((bf16_t*)(ws + BTB) + ((size_t)(ct * 2 + g2) * NTB + tt * 4) * 2048 + cidx * 8) = tv; }
            }
            __syncthreads();
        }
    }
#undef CONV_MAP
}

struct SsdUnit { int t0, L, g, c, b; bool prm; };
DEV SsdUnit ssd_unit(int u) { SsdUnit U; if (u < 256) { U.prm = true; U.c = u >> 2; U.g = u & 3; U.t0 = U.c * 256; U.L = 256; U.b = 0; } else { const int su = u - 256; U.prm = false; U.b = su >> 2; U.g = su & 3; U.c = 0; U.t0 = TPR + U.b * 16; U.L = 16; } return U; }
DEV float ssd_tables(const float* DT, const SsdUnit& U, int hd, float a, float* dtv, float* acv, int lane) {
    float run = 0.f; const int nseg = (U.L + 63) >> 6;
    for (int sg = 0; sg < nseg; ++sg) { const int j = sg * 64 + lane;
        const float dt = (j < U.L) ? DT[(size_t)(U.t0 + j) * 32 + hd] : 0.f; float v = dt * a;
#pragma unroll
        for (int o = 1; o < 64; o <<= 1) { const float uu = __shfl_up(v, o); if (lane >= o) v += uu; }
        v += run; dtv[j] = dt; acv[j] = v; run = __shfl(v, 63); }
    LDS_FENCE();
    return run;
}
DEV void ssd_s1_unit(const Params& p, unsigned char* ldsg, int u) {
    unsigned char* ws = p.ws;
    const int tid = otid(), lane = tid & 63, w = tid >> 6, l32 = lane & 31, hi = lane >> 5;
    const SsdUnit U = ssd_unit(u); const int hd = U.g * 8 + w;
    float* dtv = (float*)(ldsg + w * 3072); float* acv = dtv + 256; float* wv = acv + 256;
    const float a = -__expf(p.in[23][hd]);
    const float last = ssd_tables((const float*)(ws + DTB), U, hd, a, dtv, acv, lane);
    const int npad = U.prm ? 256 : 64;
    for (int j = lane; j < npad; j += 64) wv[j] = __expf(last - acv[j]) * dtv[j];
    LDS_FENCE();
    const bf16_t* XT = (const bf16_t*)(ws + XTB); const bf16_t* BT = (const bf16_t*)(ws + BTB);
    const int nks = (U.L + 15) >> 4;
    const float dl = __expf(last);
    if (U.prm && lane == 0) ((float*)(ws + DEC))[U.c * 32 + hd] = dl;
#pragma unroll 1
    for (int nh = 0; nh < 2; ++nh) {
        f32x16 acc[2][2];
#pragma unroll
        for (int a_ = 0; a_ < 2; ++a_)
#pragma unroll
            for (int b_ = 0; b_ < 2; ++b_) acc[a_][b_] = zero16();
#pragma unroll 4
        for (int ks = 0; ks < nks; ++ks) {
            const f32x4 w0 = *(const f32x4*)(wv + 16 * ks + 4 * hi), w1 = *(const f32x4*)(wv + 16 * ks + 8 + 4 * hi); const size_t tb = (size_t)(U.t0 >> 4) + ks;
            bf16x8 xa[2], bb[2];
#pragma unroll
            for (int pt = 0; pt < 2; ++pt) { const bf16x8 x = *(const bf16x8*)(XT + (((size_t)hd * NTB + tb) * 64 + 32 * pt + l32) * 16 + hi * 8);
                u32x4 q; q.x = pk2(bf2f(x[0]) * w0[0], bf2f(x[1]) * w0[1]); q.y = pk2(bf2f(x[2]) * w0[2], bf2f(x[3]) * w0[3]);
                q.z = pk2(bf2f(x[4]) * w1[0], bf2f(x[5]) * w1[1]); q.w = pk2(bf2f(x[6]) * w1[2], bf2f(x[7]) * w1[3]); xa[pt] = __builtin_bit_cast(bf16x8, q); }
#pragma unroll
            for (int nt = 0; nt < 2; ++nt) bb[nt] = *(const bf16x8*)(BT + (((size_t)U.g * NTB + tb) * 128 + 64 * nh + 32 * nt + l32) * 16 + hi * 8);
#pragma unroll
            for (int pt = 0; pt < 2; ++pt)
#pragma unroll
                for (int nt = 0; nt < 2; ++nt) acc[pt][nt] = mfma32(xa[pt], bb[nt], acc[pt][nt]);
        }
        {
            const size_t eo = (size_t)(4 * hi) * 128 + 64 * nh + l32;
            float* sp = U.prm ? (float*)(ws + STATES) + ((size_t)U.c * 32 + hd) * 8192 + eo : p.out + O_SSMS + ((size_t)U.b * 32 + hd) * 8192 + eo;
            const float* hp = U.prm ? sp : p.in[6] + ((size_t)U.b * 32 + hd) * 8192 + eo;
            const float dmul = U.prm ? 0.f : dl;
#pragma unroll
            for (int pt = 0; pt < 2; ++pt)
#pragma unroll
                for (int g4 = 0; g4 < 4; ++g4) {
                    float* q = sp + (32 * pt + 8 * g4) * 128; const float* hq = hp + (32 * pt + 8 * g4) * 128;
                    asm volatile("" : "+v"(q), "+v"(hq));
#pragma unroll
                    for (int e = 0; e < 4; ++e)
#pragma unroll
                        for (int nt = 0; nt < 2; ++nt) { float v = acc[pt][nt][4 * g4 + e]; if (!U.prm) v += hq[e * 128 + 32 * nt] * dmul; q[e * 128 + 32 * nt] = v; }
                    asm volatile("" ::: "memory");
                }
        }
    }
}
DEV void ssd_s2(const Params& p, int G) {
    float* ST = (float*)(p.ws + STATES); const float* dec = (const float*)(p.ws + DEC);
    for (int e = blockIdx.x * 512 + threadIdx.x; e < 262144; e += G * 512) { const int hd = e >> 13; float run = 0.f;
        for (int c0 = 0; c0 < 64; c0 += 8) {
            float sv[8], dv[8];
#pragma unroll
            for (int k = 0; k < 8; ++k) { sv[k] = ST[(size_t)(c0 + k) * 262144 + e]; dv[k] = dec[(c0 + k) * 32 + hd]; }
#pragma unroll
            for (int k = 0; k < 8; ++k) { ST[(size_t)(c0 + k) * 262144 + e] = run; run = run * dv[k] + sv[k]; }
        }
        p.out[O_SSMP + e] = run; }
}
template <bool dummy>
DEV void ssd_s3_unit(const Params& p, unsigned char* ldsg, int u) {
    unsigned char* ws = p.ws;
    const int tid = otid(), lane = tid & 63, w = tid >> 6, l32 = lane & 31, hi = lane >> 5;
    const SsdUnit U = ssd_unit(u); const int hd = U.g * 8 + w;
    const bf16_t* Bl = (const bf16_t*)ldsg; const bf16_t* Cl = (const bf16_t*)(ldsg + 65536);
    float* dtv = (float*)(ldsg + 131072 + 64 + w * 2048); float* acv = dtv + 256;
    float* red = (float*)(ldsg + 131072 + 64 + 16384);
    const bf16_t* XT = (const bf16_t*)(ws + XTB); const bf16_t* BNp = (const bf16_t*)(ws + BN); const bf16_t* CNp = (const bf16_t*)(ws + CN);
    { const int nrows = U.prm ? 256 : 32;
      for (int q = tid; q < nrows * 16; q += 512) { const int row = q >> 4, ch = q & 15; const size_t go = ((size_t)U.t0 + row) * 512 + U.g * 128 + ch * 8;
          const u32x4 vb = *(const u32x4*)(BNp + go), vc = *(const u32x4*)(CNp + go); const int lo = row * 256 + ((ch ^ (row & 15)) << 4);
          *(u32x4*)(ldsg + lo) = vb; *(u32x4*)(ldsg + 65536 + lo) = vc; } }
    const float a = -__expf(p.in[23][hd]);
    (void)ssd_tables((const float*)(ws + DTB), U, hd, a, dtv, acv, lane);
    float* fv = (float*)(ldsg + 131072 + 64 + 16384 + 2048 + w * 1024);
    for (int j = lane; j < 256; j += 64) fv[j] = __expf(acv[(j & ~31) + 31] - acv[j]) * dtv[j];
    LDS_FENCE();
    __syncthreads();
    bf16_t* Zp = (bf16_t*)(ws + ZB);
    const float* hst = U.prm ? (const float*)(ws + STATES) + ((size_t)U.c * 32 + hd) * 8192 : p.in[6] + ((size_t)U.b * 32 + hd) * 8192;
    const float dsk = p.in[24][hd];
    const int ntile = (U.L + 31) >> 5;
    const bf16_t* xrow0 = XT + (((size_t)hd * NTB + (U.t0 >> 4)) * 64 + l32) * 16 + hi * 8;
    bf16x8 hf[8][2];
#pragma unroll
    for (int ks = 0; ks < 8; ++ks)
#pragma unroll
        for (int pt = 0; pt < 2; ++pt) { const float* hp = hst + (32 * pt + l32) * 128 + 16 * ks + hi * 8; const f32x4 h0 = *(const f32x4*)hp, h1 = *(const f32x4*)(hp + 4);
            u32x4 q; q.x = pk2(h0[0], h0[1]); q.y = pk2(h0[2], h0[3]); q.z = pk2(h1[0], h1[1]); q.w = pk2(h1[2], h1[3]); hf[ks][pt] = __builtin_bit_cast(bf16x8, q); }
    for (int it = 0; it < ntile; ++it) {
        const int i_loc = 32 * it + l32; const size_t ti = (size_t)U.t0 + i_loc;
        const bool valid = i_loc < U.L;
        bf16_t* zp = Zp + ti * 2048 + hd * 64 + 4 * hi;
        bf16x8 cf[8];
        { const int crow = 32 * it + l32; const unsigned char* cb_ = (const unsigned char*)Cl + crow * 256;
#pragma unroll
          for (int ks = 0; ks < 8; ++ks) cf[ks] = *(const bf16x8*)(cb_ + (((2 * ks + hi) ^ (crow & 15)) << 4)); }
        f32x16 acc[2]; acc[0] = zero16(); acc[1] = zero16();
#pragma unroll
        for (int ks = 0; ks < 8; ++ks)
#pragma unroll
            for (int pt = 0; pt < 2; ++pt) acc[pt] = mfma32(hf[ks][pt], cf[ks], acc[pt]);
        const float aci = acv[i_loc];
        { const float ei = __expf(aci); acc[0] *= ei; acc[1] *= ei; }
        for (int jt = 0; jt <= it; ++jt) {
            bf16x8 xc[2][2];
#pragma unroll
            for (int kk = 0; kk < 2; ++kk)
#pragma unroll
                for (int pt = 0; pt < 2; ++pt) xc[kk][pt] = *(const bf16x8*)(xrow0 + (size_t)(2 * jt + kk) * 1024 + pt * 512);
            f32x16 cb = zero16();
            { const int brow = 32 * jt + l32; const unsigned char* bb_ = (const unsigned char*)Bl + brow * 256;
#pragma unroll
              for (int ks = 0; ks < 8; ++ks) { const bf16x8 bfr = *(const bf16x8*)(bb_ + (((2 * ks + hi) ^ (brow & 15)) << 4)); cb = mfma32(bfr, cf[ks], cb); } }
            if (jt < it) {
                const float ei = __expf(aci - acv[32 * jt + 31]);
#pragma unroll
                for (int g4 = 0; g4 < 4; ++g4) { const f32x4 fj = *(const f32x4*)(fv + 32 * jt + 8 * g4 + 4 * hi);
#pragma unroll
                    for (int e = 0; e < 4; ++e) cb[4 * g4 + e] = cb[4 * g4 + e] * (fj[e] * ei); }
            } else {
#pragma unroll
                for (int g4 = 0; g4 < 4; ++g4) { const int jb = 32 * jt + 8 * g4 + 4 * hi; const f32x4 aj = *(const f32x4*)(acv + jb), dj = *(const f32x4*)(dtv + jb);
#pragma unroll
                    for (int e = 0; e < 4; ++e) { const int j = jb + e; const float d = fminf(aci - aj[e], 0.f);
                        float v = (j <= i_loc && j < U.L) ? cb[4 * g4 + e] * __expf(d) * dj[e] : 0.f; if (j == i_loc) v += dsk; cb[4 * g4 + e] = v; } }
            }
            bf16x8 mb[2]; mb[0] = pack8<0>(cb); mb[1] = pack8<8>(cb);
#pragma unroll
            for (int kk = 0; kk < 2; ++kk)
#pragma unroll
                for (int pt = 0; pt < 2; ++pt) acc[pt] = mfma32(xc[kk][pt], mb[kk], acc[pt]);
        }
        s16x4 zz[2][4];
#pragma unroll
        for (int pt = 0; pt < 2; ++pt)
#pragma unroll
            for (int g4 = 0; g4 < 4; ++g4) zz[pt][g4] = valid ? *(const s16x4*)(zp + 32 * pt + 8 * g4) : (s16x4){0, 0, 0, 0};
        float ss = 0.f;
#pragma unroll
        for (int pt = 0; pt < 2; ++pt)
#pragma unroll
            for (int g4 = 0; g4 < 4; ++g4)
#pragma unroll
                for (int e = 0; e < 4; ++e) { const float v = acc[pt][4 * g4 + e] * silu(bf2f(zz[pt][g4][e])); acc[pt][4 * g4 + e] = v; ss += v * v; }
        ss += __shfl_xor(ss, 32);
        float* rd = red + (it & 1) * 256;
        if (hi == 0) rd[w * 32 + l32] = ss;
        __syncthreads();
        float tot = 0.f;
#pragma unroll
        for (int ww = 0; ww < 8; ++ww) tot += rd[ww * 32 + l32];
        const float rstd = rsqrtf(tot * (1.f / 512.f) + EPS);
        if (valid) {
            const float* nw = p.in[25] + hd * 64 + 4 * hi;
#pragma unroll
            for (int pt = 0; pt < 2; ++pt)
#pragma unroll
                for (int g4 = 0; g4 < 4; ++g4) { const f32x4 gw4 = *(const f32x4*)(nw + 32 * pt + 8 * g4);
                    u32x2 o; o.x = pk2(acc[pt][4 * g4] * rstd * gw4[0], acc[pt][4 * g4 + 1] * rstd * gw4[1]); o.y = pk2(acc[pt][4 * g4 + 2] * rstd * gw4[2], acc[pt][4 * g4 + 3] * rstd * gw4[3]);
                    bf16_t* zo = dummy ? (bf16_t*)(ws + 23363584) + ((ti * 2048 + hd * 64 + 4 * hi) & 0x7FFFF) : zp;
                    *(u32x2*)(zo + 32 * pt + 8 * g4) = o; }
        }
    }
    __syncthreads();
}

#define XB_TMO      128
#define XB_XCNT(j)  (256  + 64 * (j))
#define XB_XSUB(j)  (1280 + 64 * (j))
#define XB_XGEN(j)  (2304 + 64 * (j))
#define XB_TOP      3328
#define XB_TOPGEN   3392
#define XCD_BAR_WORDS 3456
#define XB_SPIN_CAP (1u << 22)
DEV unsigned xb_ld(unsigned* p)              { return __hip_atomic_load(p, __ATOMIC_RELAXED, __HIP_MEMORY_SCOPE_AGENT); }
DEV unsigned xb_add(unsigned* p, unsigned v) { return __hip_atomic_fetch_add(p, v, __ATOMIC_RELAXED, __HIP_MEMORY_SCOPE_AGENT); }
DEV unsigned xb_xcc_id() { return (unsigned)__builtin_amdgcn_s_getreg((3 << 11) | 20) & 0xFu; }
#define XB_SPIN(cond, bar) do { unsigned _sp = 0; while (cond) { __builtin_amdgcn_s_sleep(1); \
    if ((++_sp & 255u) == 0u) { if (xb_ld(&(bar)[XB_TMO])) break; if (_sp > XB_SPIN_CAP) { atomicAdd(&(bar)[XB_TMO], 1u); break; } } } } while (0)
struct XcdBarrier { unsigned* bar; unsigned x; volatile LAS unsigned* st; };
DEV XcdBarrier xcd_barrier_post(unsigned* bar, volatile LAS unsigned* st) {
    XcdBarrier b; b.bar = bar; b.x = xb_xcc_id(); b.st = st;
    if (threadIdx.x == 0) (void)xb_add(&bar[XB_XCNT(b.x)], 1u);
    return b;
}
DEV void xcd_barrier_complete(unsigned* bar, unsigned x, unsigned& nloc, unsigned& nx) {
    const unsigned G = gridDim.x * gridDim.y * gridDim.z;
    unsigned sum, cnt, mine, sp = 0u;
    for (;;) {
        sum = 0u; cnt = 0u; mine = 0u;
#pragma unroll
        for (unsigned j = 0; j < 16; ++j) { const unsigned c = xb_ld(&bar[XB_XCNT(j)]); sum += c; cnt += (c > 0u) ? 1u : 0u; mine = (j == x) ? c : mine; }
        if (sum == G) break;
        __builtin_amdgcn_s_sleep(1);
        if ((++sp & 255u) == 0u) { if (xb_ld(&bar[XB_TMO])) break; if (sp > XB_SPIN_CAP) { atomicAdd(&bar[XB_TMO], 1u); break; } }
    }
    nloc = mine > 0u ? mine : 1u; nx = cnt > 0u ? cnt : 1u;
}
DEV void xcd_barrier(const XcdBarrier& b) {
    asm volatile("s_waitcnt vmcnt(0)" ::: "memory");
    __syncthreads();
    if (threadIdx.x == 0) {
        unsigned* bar = b.bar;
        __builtin_amdgcn_s_waitcnt(0);
        unsigned nloc = b.st[0], nx = b.st[1];
        if (nloc == 0u) { xcd_barrier_complete(bar, b.x, nloc, nx); b.st[0] = nloc; b.st[1] = nx; }
        const unsigned old = xb_add(&bar[XB_XSUB(b.x)], 1u);
        const unsigned gen = old / nloc;
        if (old + 1u == (gen + 1u) * nloc) {
            __builtin_amdgcn_fence(__ATOMIC_RELEASE, "agent");
            asm volatile("s_waitcnt vmcnt(0)" ::: "memory");
            const unsigned og = xb_add(&bar[XB_TOP], 1u);
            const unsigned tg = og / nx;
            if (og + 1u == (tg + 1u) * nx) xb_add(&bar[XB_TOPGEN], 1u);
            else XB_SPIN(xb_ld(&bar[XB_TOPGEN]) == tg, bar);
            __builtin_amdgcn_fence(__ATOMIC_ACQUIRE, "agent");
            xb_add(&bar[XB_XGEN(b.x)], 1u);
            asm volatile("s_waitcnt vmcnt(0)" ::: "memory");
        } else {
            XB_SPIN(xb_ld(&bar[XB_XGEN(b.x)]) == gen, bar);
            __builtin_amdgcn_fence(__ATOMIC_ACQUIRE, "agent");
            asm volatile("s_waitcnt vmcnt(0)" ::: "memory");
        }
    }
    __syncthreads();
}


template <bool OUT_F32>
DEV void sample_rows_fix(const float* base, float* Xs, const float* part, int nsl, const float* g, bf16_t* Hs, int gw, int NGW, int lane) {
    for (int r = NGW - 1 - gw; r < 256; r += NGW) {
        const float* pp = part + (size_t)r * 1024; float* xr = Xs + (size_t)r * 1024;
        f32x4 v[4]; float ss = 0.f;
#pragma unroll
        for (int j = 0; j < 4; ++j) v[j] = *(const f32x4*)(base + (size_t)r * 1024 + (64 * j + lane) * 4);
        for (int ks = 0; ks < nsl; ++ks) {
#pragma unroll
            for (int j = 0; j < 4; ++j) v[j] += *(const f32x4*)(pp + (size_t)ks * 262144 + (64 * j + lane) * 4); }
#pragma unroll
        for (int j = 0; j < 4; ++j) ss += (v[j][0] * v[j][0] + v[j][1] * v[j][1]) + (v[j][2] * v[j][2] + v[j][3] * v[j][3]);
        const float rstd = rsqrtf(wave_sum(ss) * (1.f / 1024.f) + EPS);
#pragma unroll
        for (int j = 0; j < 4; ++j) { const int o = (64 * j + lane) * 4; const f32x4 gg = *(const f32x4*)(g + o);
            if (OUT_F32) *(f32x4*)(xr + o) = v[j] * rstd * gg;
            else { *(f32x4*)(xr + o) = v[j];
                u32x2 q; q.x = pk2(v[j][0] * rstd * gg[0], v[j][1] * rstd * gg[1]); q.y = pk2(v[j][2] * rstd * gg[2], v[j][3] * rstd * gg[3]); *(u32x2*)(Hs + (size_t)r * 1024 + o) = q; } }
    }
}

#ifndef PHM
#define PHM 0x3fff
#endif
#ifndef SSDM
#define SSDM 7
#endif
typedef __attribute__((address_space(4))) const Params* KParams;
#define PLOAD() KParams kq_ = kp; asm volatile("" : "+s"(kq_)); Params p; __builtin_memcpy(&p, kq_, sizeof(Params)); unsigned char* ws = p.ws; unsigned char* ob = (unsigned char*)p.out; float* X = p.out; const int tid = otid(), lane = tid & 63, wave = tid >> 6, gw = bid * 8 + wave; (void)ws; (void)ob; (void)X; (void)lane; (void)gw;
__global__ void __launch_bounds__(512, 2) mega(Params p_arg) {
    extern __shared__ __attribute__((aligned(16))) unsigned char lds_raw[];
    cg::grid_group grid = cg::this_grid();
    LAS unsigned char* lds = (LAS unsigned char*)lds_raw;
    unsigned char* ldsg = lds_raw;
    const int G = gridDim.x, bid = blockIdx.x, NGW = G * 8;
    volatile LAS unsigned* xst = (volatile LAS unsigned*)(lds + 131072);
    if (threadIdx.x < 4) xst[threadIdx.x] = 0u;
    if (bid == 0) { unsigned* bw = (unsigned*)(p_arg.ws + XBAR); for (int i = threadIdx.x; i < XCD_BAR_WORDS; i += 512) bw[i] = 0u; }
    __syncthreads();
    XcdBarrier xbar; xbar.bar = (unsigned*)(p_arg.ws + XBAR); xbar.x = 0; xbar.st = xst;
#define GSYNC() xcd_barrier(xbar)
    const KParams kp = (KParams)__builtin_amdgcn_kernarg_segment_ptr();

#if PHM & 1
    { PLOAD();
    phase0(p, ldsg, gw, NGW, lane, wave);
    }
    grid.sync();
    xbar = xcd_barrier_post((unsigned*)(p_arg.ws + XBAR), xst);
#endif
#if PHM & 2
    { PLOAD();
    { pg8::Gemm g{(const bf16_t*)(ws + H0), (const bf16_t*)(ws + W_INAB), 1024, 1024, 1024}; pg8::StaticOrder S; S.init(T, 1280, G, bid);
      EpiBf16 E{(bf16_t*)(ws + PROJ), 1280, nullptr}; pg8::gemm_phase(lds, g, S, E);
    }
    { const int nb2 = 325 > G ? 325 - G : 0;
      if (bid >= nb2) { const int gw2 = (bid - nb2) * 8 + wave, NGW2 = (G - nb2) * 8; float* scr = (float*)(ldsg + wave * 8448); int rot = 0;
        convert_weight(p.in[18], 1024, 1024, (bf16_t*)(ws + W_OUTAB), 1024, 0, 0, 0, scr, gw2, NGW2, lane, rot);
        convert_weight(p.in[27], 1024, 2816, (bf16_t*)(ws + W_GU0), 1024, 0, 0, 1, scr, gw2, NGW2, lane, rot);
        convert_weight(p.in[28], 1024, 2816, (bf16_t*)(ws + W_GU0), 1024, 0, 0, 2, scr, gw2, NGW2, lane, rot);
        convert_weight(p.in[29], 2816, 1024, (bf16_t*)(ws + W_DN0), 2816, 0, 0, 0, scr, gw2, NGW2, lane, rot); } }
    }
    GSYNC();
#endif
#if PHM & 4
    { PLOAD();
    phase2(p, gw, NGW, lane);
    }
    GSYNC();
#endif
#if PHM & 8
    { PLOAD();
    { pg8::Gemm g{(const bf16_t*)(ws + POOLED), (const bf16_t*)(ws + W_POOL), 512, 512, 512}; pg8::StaticOrder S; S.init(T, 512, G, bid);
      EpiBf16 E{(bf16_t*)(ws + CAT), 1024, p.in[12]}; pg8::gemm_phase(lds, g, S, E); }
    { pg8::Gemm g{(const bf16_t*)(ws + QLN), (const bf16_t*)(ws + W_UQ), 384, 384, 384}; pg8::StaticOrder S; S.init(T, 768, G, (bid + 80) % G);
      EpiBf16 E{(bf16_t*)(ob + D_QRAW), 768, nullptr}; pg8::gemm_phase(lds, g, S, E); }
    { pg8::Gemm g{(const bf16_t*)(ob + D_CKVALL), (const bf16_t*)(ws + W_UK), 256, 256, 256}; pg8::StaticOrder S; S.init(NK, 512, G, (bid + 136) % G);
      EpiBf16 E{(bf16_t*)(ws + KNOPE), 512, nullptr}; pg8::gemm_phase(lds, g, S, E); }
    { pg8::Gemm g{(const bf16_t*)(ws + W_UV), (const bf16_t*)(ob + D_CKVALL), 256, 256, 256}; pg8::StaticOrder S; S.init(512, NK, G, (bid + 136) % G);
      EpiBf16 E{(bf16_t*)(ws + VT), (size_t)NK, nullptr}; pg8::gemm_phase(lds, g, S, E); }
    }
    GSYNC();
#endif
#if PHM & 16
    { PLOAD();
    { AttnPtrs A{(const bf16_t*)(ob + D_QRAW), (const bf16_t*)(ws + KNOPE), (const bf16_t*)(ob + D_KPEALL), (const bf16_t*)(ws + VT), (const float*)(ob + D_ROPE), (bf16_t*)(ws + CAT)};
      for (int pi = bid; pi < 256; pi += G) { const int h = pi & 7, x = pi >> 3, xx = x & 15, base = 4 * (xx >> 1) + (xx & 1);
          const int qlo = x < 16 ? base : base + 2, qhi = x < 16 ? 61 - base : 63 - base;
          attn_prompt_unit(A, ldsg, h, qhi); attn_prompt_unit(A, ldsg, h, qlo); }
      for (int su = bid; su < 128; su += G) attn_sample_unit(A, ldsg, su >> 3, su & 7); }
    }
    GSYNC();
#endif
#if PHM & 32
    { PLOAD();
    { pg8::Gemm g{(const bf16_t*)(ws + CAT), (const bf16_t*)(ws + W_OUTAB), 1024, 1024, 1024}; pg8::ChainOrder S; S.a.init(TPR, 1024, G, bid); S.b = pg8::SplitOrder{64, 4, 4, 256, G, bid}; S.init();
      EpiResChain E{EpiRes{X, p.in[0], p.in[1], 0}, EpiRes{(float*)(ws + PART), nullptr, nullptr, 3}}; pg8::gemm_phase(lds, g, S, E);
    }
    }
    GSYNC();
#endif
#if PHM & 64
    { PLOAD();
    rms_phase(X, p.in[8], (bf16_t*)(ws + HF), gw, NGW, lane, TPR);
    sample_rows_fix<false>(p.in[1], X + (size_t)TPR * 1024, (const float*)(ws + PART), 4, p.in[8], (bf16_t*)(ws + HF) + (size_t)TPR * 1024, gw, NGW, lane);
    GSYNC();
    { pg8::Gemm g{(const bf16_t*)(ws + HF), (const bf16_t*)(ws + W_GU0), 1024, 1024, 1024}; pg8::StaticOrder S; S.init(T, 5632, G, bid);
      EpiSwiglu E{(bf16_t*)(ws + GF0)}; pg8::gemm_phase(lds, g, S, E);
    }
    GSYNC();
    { pg8::Gemm g{(const bf16_t*)(ws + GF0), (const bf16_t*)(ws + W_DN0), 2816, 2816, 2816}; pg8::ChainOrder S; S.a.init(TPR, 1024, G, bid); S.b = pg8::SplitOrder{64, 4, 11, 256, G, bid}; S.init();
      EpiResChain E{EpiRes{X, nullptr, nullptr, 1}, EpiRes{(float*)(ws + PART8), nullptr, nullptr, 3}}; pg8::gemm_phase(lds, g, S, E); }
    { const int nb2 = 44 < G ? 44 : 0;
      if (bid >= nb2) { const int gw2 = (bid - nb2) * 8 + wave, NGW2 = (G - nb2) * 8; float* scr = (float*)(ldsg + wave * 8448); int rot = 0;
        convert_weight(p.in[19], 1024, 5152, (bf16_t*)(ws + W_INC), 1024, 0, 0, 0, scr, gw2, NGW2, lane, rot);
        const int gt = gw2 * 64 + lane, NGT = NGW2 * 64; const u32x4 z4 = {0u, 0u, 0u, 0u};
        for (int i = gt; i < 224 * 128; i += NGT) *(u32x4*)(ws + W_INC + (size_t)5152 * 2048 + (size_t)i * 16) = z4; } }
    }
    GSYNC();
#endif
#if PHM & 128
    { PLOAD();
    rms_phase(X, p.in[7] + 1024, (bf16_t*)(ws + H1), gw, NGW, lane, TPR);
    sample_rows_fix<false>(X + (size_t)TPR * 1024, X + (size_t)TPR * 1024, (const float*)(ws + PART8), 11, p.in[7] + 1024, (bf16_t*)(ws + H1) + (size_t)TPR * 1024, gw, NGW, lane);
    { float* scr = (float*)(ldsg + wave * 8448); int rot = 0;
      convert_weight(p.in[26], 2048, 1024, (bf16_t*)(ws + W_OUTC), 2048, 0, 0, 0, scr, gw, NGW, lane, rot); }
    }
    GSYNC();
#endif
#if PHM & 256
    { PLOAD();
    { pg8::Gemm g{(const bf16_t*)(ws + H1), (const bf16_t*)(ws + W_INC), 1024, 1024, 1024}; pg8::StaticOrder S; S.init(T, 5376, G, bid);
      EpiInC E{(bf16_t*)(ws + ZB), (bf16_t*)(ws + XRAW), (bf16_t*)(ws + BCRAW), (float*)(ws + DTB), p.in[22]}; pg8::gemm_phase(lds, g, S, E);
    }
    }
    GSYNC();
#endif
#if PHM & 512
    { PLOAD();
    conv_phase<false>(p, ldsg, bid, G);
    }
    GSYNC();
#endif
#if PHM & 1024
    { PLOAD();
#if SSDM & 1
    for (int u = bid; u < 320; u += G) {
        conv_phase<true>(p, ldsg, bid, G, u);
        asm volatile("s_waitcnt vmcnt(0)" ::: "memory"); __syncthreads();
        ssd_s1_unit(p, ldsg, u);
        __syncthreads();
    }
#endif
    GSYNC();
#if SSDM & 2
    ssd_s2(p, G);
#endif
    GSYNC();
#if SSDM & 4
    for (int u = bid; u < 320; u += G) ssd_s3_unit<false>(p, ldsg, u);
#endif
    }
    GSYNC();
#endif
#if PHM & 2048
    { PLOAD();
    { pg8::Gemm g{(const bf16_t*)(ws + ZB), (const bf16_t*)(ws + W_OUTC), 2048, 2048, 2048}; pg8::ChainOrder S; S.a.init(TPR, 1024, G, bid); S.b = pg8::SplitOrder{64, 4, 8, 256, G, bid}; S.init();
      EpiResChain E{EpiRes{X, nullptr, nullptr, 1}, EpiRes{(float*)(ws + PART13), nullptr, nullptr, 3}}; pg8::gemm_phase(lds, g, S, E);
      const int nb2 = 32 < G ? 32 : 0;
      if (bid >= nb2) { const int gw2 = (bid - nb2) * 8 + wave, NGW2 = (G - nb2) * 8; float* scr = (float*)(ldsg + wave * 8448); int rot = 0;
        convert_weight(p.in[27] + (size_t)1024 * 2816, 1024, 2816, (bf16_t*)(ws + W_GU1), 1024, 0, 0, 1, scr, gw2, NGW2, lane, rot);
        convert_weight(p.in[28] + (size_t)1024 * 2816, 1024, 2816, (bf16_t*)(ws + W_GU1), 1024, 0, 0, 2, scr, gw2, NGW2, lane, rot);
        convert_weight(p.in[29] + (size_t)2816 * 1024, 2816, 1024, (bf16_t*)(ws + W_DN1), 2816, 0, 0, 0, scr, gw2, NGW2, lane, rot); } }
    }
    GSYNC();
#endif
#if PHM & 4096
    { PLOAD();
    rms_phase(X, p.in[8] + 1024, (bf16_t*)(ws + H2), gw, NGW, lane, TPR);
    sample_rows_fix<false>(X + (size_t)TPR * 1024, X + (size_t)TPR * 1024, (const float*)(ws + PART13), 8, p.in[8] + 1024, (bf16_t*)(ws + H2) + (size_t)TPR * 1024, gw, NGW, lane);
    GSYNC();
    { pg8::Gemm g{(const bf16_t*)(ws + H2), (const bf16_t*)(ws + W_GU1), 1024, 1024, 1024}; pg8::StaticOrder S; S.init(T, 5632, G, bid);
      EpiSwiglu E{(bf16_t*)(ws + GF1)}; pg8::gemm_phase(lds, g, S, E); }
    GSYNC();
    { pg8::Gemm g{(const bf16_t*)(ws + GF1), (const bf16_t*)(ws + W_DN1), 2816, 2816, 2816}; pg8::ChainOrder S; S.a.init(TPR, 1024, G, bid); S.b = pg8::SplitOrder{64, 4, 11, 256, G, bid}; S.init();
      EpiResChain E{EpiRes{X, nullptr, nullptr, 1}, EpiRes{(float*)(ws + PART16), nullptr, nullptr, 3}}; pg8::gemm_phase(lds, g, S, E); }
    }
    GSYNC();
#endif
#if PHM & 8192
    { PLOAD();
    { f32x4 gg[4];
#pragma unroll
      for (int j = 0; j < 4; ++j) gg[j] = *(const f32x4*)(p.in[9] + (64 * j + lane) * 4);
      for (int t = gw; t < TPR; t += 2 * NGW) {
        const int t2 = t + NGW; const bool two = t2 < TPR; const int tb_ = two ? t2 : t;
        float* xa = X + (size_t)t * 1024; float* xb = X + (size_t)tb_ * 1024;
        f32x4 v[4], u[4]; float sa = 0.f, sb = 0.f;
#pragma unroll
        for (int j = 0; j < 4; ++j) { v[j] = *(const f32x4*)(xa + (64 * j + lane) * 4); u[j] = *(const f32x4*)(xb + (64 * j + lane) * 4); }
#pragma unroll
        for (int j = 0; j < 4; ++j) { sa += (v[j][0] * v[j][0] + v[j][1] * v[j][1]) + (v[j][2] * v[j][2] + v[j][3] * v[j][3]); sb += (u[j][0] * u[j][0] + u[j][1] * u[j][1]) + (u[j][2] * u[j][2] + u[j][3] * u[j][3]); }
#pragma unroll
        for (int o = 1; o < 64; o <<= 1) { sa += __shfl_xor(sa, o); sb += __shfl_xor(sb, o); }
        const float ra = rsqrtf(sa * (1.f / 1024.f) + EPS), rb = rsqrtf(sb * (1.f / 1024.f) + EPS);
#pragma unroll
        for (int j = 0; j < 4; ++j) *(f32x4*)(xa + (64 * j + lane) * 4) = v[j] * ra * gg[j];
        if (two) {
#pragma unroll
            for (int j = 0; j < 4; ++j) *(f32x4*)(xb + (64 * j + lane) * 4) = u[j] * rb * gg[j]; }
      } }
    sample_rows_fix<true>(X + (size_t)TPR * 1024, X + (size_t)TPR * 1024, (const float*)(ws + PART16), 11, p.in[9], nullptr, gw, NGW, lane);
    }
#endif
}

extern "C" void kernel_launch(void* const* d_in, const int* in_sizes, int n_in, void* d_out, int out_size, void* d_ws, size_t ws_size, hipStream_t stream) {
    constexpr int kLds = 131072 + 64 + 16384 + 2048 + 8192;
    static int grid = 0;
    if (grid == 0) {
        if (n_in != 30 || ws_size < WS_NEED) { fprintf(stderr, "kernel_launch: unexpected n_in %d or workspace %zu < %zu\n", n_in, ws_size, (size_t)WS_NEED); grid = -1; return; }
        int dev = 0, cus = 0, per_cu = 0;
        hipGetDevice(&dev); hipDeviceGetAttribute(&cus, hipDeviceAttributeMultiprocessorCount, dev);
        if (hipFuncSetAttribute((const void*)mega, hipFuncAttributeMaxDynamicSharedMemorySize, kLds) != hipSuccess) { fprintf(stderr, "kernel_launch: hipFuncSetAttribute failed\n"); grid = -1; return; }
        if (hipOccupancyMaxActiveBlocksPerMultiprocessor(&per_cu, (const void*)mega, 512, kLds) != hipSuccess || per_cu < 1) { fprintf(stderr, "kernel_launch: occupancy query says %d\n", per_cu); grid = -1; (void)hipGetLastError(); return; }
        grid = cus;
    }
    if (grid < 0) return;
    Params prm{};
    for (int i = 0; i < 30; ++i) prm.in[i] = (const float*)d_in[i];
    prm.out = (float*)d_out; prm.ws = (unsigned char*)d_ws;
    void* args[] = {&prm};
    hipError_t e = hipLaunchCooperativeKernel((const void*)mega, dim3(grid), dim3(512), args, kLds, stream);
    if (e != hipSuccess) fprintf(stderr, "kernel_launch: cooperative launch failed: %s (grid %d)\n", hipGetErrorString(e), grid);
}
```
